# Optimizing an MI355X kernel written in HIP

```python
import math
import jax
import jax.numpy as jnp
from jax import lax
import numpy as np

D_MODEL = 1024
BATCH = 16
SEQ = 4096
DEPTH = 4

HEAD_DIM = 64
GRID_W = 64
EPS = 1e-6
NEG_INF = -1e30

NA_HEADS = 4
NA_KH_MAX = 8
NA_KW = 16

DIL_HEADS = 8
DIL_PATTERNS = ((128, 1), (512, 4), (2048, 16))
DIL_BLK = 128

MLA_HEADS = 4
MLA_Q_LORA = 384
MLA_KV_LORA = 256
MLA_NOPE = 64
MLA_ROPE = 32
MLA_V = 64
MLA_BLK = 128
ROPE_THETA = 10000.0

T5_BUCKETS = 32
T5_MAX_DIST = 1024

D_FF = 2816
CONV_W = 3

D_A = NA_HEADS * HEAD_DIM
D_B = DIL_HEADS * HEAD_DIM
D_C = MLA_HEADS * MLA_V
D_MIX = D_A + D_B + D_C
D_IN = 3 * D_A + 3 * D_B + MLA_Q_LORA + MLA_KV_LORA + MLA_ROPE
N_MOD = 6

kernel_name = "hybrid_na_dilated_mla_encoder"


def rms_norm(x, g):
    xf = x.astype(jnp.float32)
    y = xf * lax.rsqrt(jnp.mean(xf * xf, axis=-1, keepdims=True) + EPS)
    return (y * g.astype(jnp.float32)).astype(x.dtype)


def rope_tables(seq_len):
    inv_freq = jnp.asarray(ROPE_THETA ** (-np.arange(0, MLA_ROPE, 2, dtype=np.float32) / MLA_ROPE), jnp.float32)
    ang = jnp.arange(seq_len, dtype=jnp.float32)[:, None] * inv_freq[None, :]
    return jnp.cos(ang), jnp.sin(ang)


def apply_rope(x, cos, sin):
    half = x.shape[-1] // 2
    x1, x2 = x[..., :half], x[..., half:]
    c = cos[None, :, None, :].astype(x.dtype)
    s = sin[None, :, None, :].astype(x.dtype)
    return jnp.concatenate([x1 * c - x2 * s, x1 * s + x2 * c], axis=-1)


def neighbourhood_attention(q, k, v, rpb):
    B, S, H, Dh = q.shape
    rows = S // GRID_W
    kh = min(NA_KH_MAX, rows)
    qg = q.reshape(B, rows, GRID_W, H, Dh)
    kg = k.reshape(B, rows, GRID_W, H, Dh)
    vg = v.reshape(B, rows, GRID_W, H, Dh)
    col = np.arange(GRID_W)
    c_start = np.clip(col - NA_KW // 2, 0, GRID_W - NA_KW)
    c_idx = c_start[:, None] + np.arange(NA_KW)[None, :]
    d_col = c_idx - col[:, None] + (NA_KW - 1)
    row = np.arange(rows)
    r_start = np.clip(row - kh // 2, 0, rows - kh)
    d_row = r_start[:, None] + np.arange(kh)[None, :] - row[:, None] + (NA_KH_MAX - 1)
    scale = Dh ** -0.5

    def one_row(args):
        r, r0, dr = args
        q_r = lax.dynamic_index_in_dim(qg, r, axis=1, keepdims=False)
        k_r = lax.dynamic_slice_in_dim(kg, r0, kh, axis=1)[:, :, c_idx]
        v_r = lax.dynamic_slice_in_dim(vg, r0, kh, axis=1)[:, :, c_idx]
        bias = rpb[:, dr[:, None, None], d_col[None, :, :]]
        s = jnp.einsum("bwhd,biwjhd->bhwij", q_r, k_r).astype(jnp.float32) * scale
        s = s + jnp.transpose(bias, (0, 2, 1, 3)).astype(jnp.float32)[None]
        p = jax.nn.softmax(s.reshape(B, H, GRID_W, kh * NA_KW), axis=-1)
        p = p.reshape(B, H, GRID_W, kh, NA_KW).astype(v.dtype)
        return jnp.einsum("bhwij,biwjhd->bwhd", p, v_r)

    out = lax.map(one_row, (jnp.arange(rows, dtype=jnp.int32),
                            jnp.asarray(r_start, jnp.int32),
                            jnp.asarray(d_row, jnp.int32)))
    return jnp.transpose(out, (1, 0, 2, 3, 4)).reshape(B, S, H, Dh)


def t5_bucket(rel):
    nb = T5_BUCKETS // 2
    max_exact = nb // 2
    n = np.abs(rel)
    large = max_exact + (np.log(np.maximum(n, 1) / max_exact)
                         / math.log(T5_MAX_DIST / max_exact) * (nb - max_exact)).astype(np.int64)
    large = np.minimum(large, nb - 1)
    return (np.where(rel > 0, nb, 0) + np.where(n < max_exact, n, large)).astype(np.int32)


def dilated_branch(q, k, v, t5_table, window, dilation):
    B, S, H, Dh = q.shape
    d = dilation
    half = window // (2 * d)
    L = S // d
    nblk = -(-L // DIL_BLK)
    Lp = nblk * DIL_BLK
    kb_len = DIL_BLK + 2 * half

    def residue_major(t):
        return jnp.transpose(t.reshape(B, L, d, H, Dh), (0, 2, 1, 3, 4))

    qr = jnp.pad(residue_major(q), ((0, 0), (0, 0), (0, Lp - L), (0, 0), (0, 0)))
    qr = qr.reshape(B, d, nblk, DIL_BLK, H, Dh)
    kv_pad = ((0, 0), (0, 0), (half, Lp - L + half), (0, 0), (0, 0))
    k_idx = np.arange(nblk)[:, None] * DIL_BLK + np.arange(kb_len)[None, :]
    kr = jnp.take(jnp.pad(residue_major(k), kv_pad), k_idx, axis=2)
    vr = jnp.take(jnp.pad(residue_major(v), kv_pad), k_idx, axis=2)

    a = np.arange(DIL_BLK)[:, None]
    j = np.arange(kb_len)[None, :]
    rel_m = j - half - a
    m_key = np.arange(nblk)[:, None, None] * DIL_BLK + (j - half)[None]
    valid = (np.abs(rel_m) <= half)[None] & (m_key >= 0) & (m_key < L)
    bias = jnp.transpose(t5_table[t5_bucket(rel_m * d)], (2, 0, 1)).astype(jnp.float32)

    s = jnp.einsum("brnqhd,brnkhd->brnhqk", qr, kr).astype(jnp.float32) * (Dh ** -0.5)
    s = jnp.where(valid[None, None, :, None], s + bias, NEG_INF)
    lse = jax.nn.logsumexp(s, axis=-1)
    p = jnp.exp(s - lse[..., None]).astype(v.dtype)
    o = jnp.einsum("brnhqk,brnkhd->brnqhd", p, vr)
    o = o.reshape(B, d, Lp, H, Dh)[:, :, :L]
    o = jnp.transpose(o, (0, 2, 1, 3, 4)).reshape(B, S, H, Dh)
    lse = jnp.transpose(lse, (0, 1, 2, 4, 3)).reshape(B, d, Lp, H)[:, :, :L]
    lse = jnp.transpose(lse, (0, 2, 1, 3)).reshape(B, S, H)
    return o, lse


def dilated_attention(q, k, v, t5_table):
    outs, lses = [], []
    for window, dilation in DIL_PATTERNS:
        o, lse = dilated_branch(q, k, v, t5_table, window, dilation)
        outs.append(o)
        lses.append(lse)
    w = jax.nn.softmax(jnp.stack(lses, axis=0), axis=0)
    mixed = jnp.sum(w[..., None] * jnp.stack(outs, axis=0).astype(jnp.float32), axis=0)
    return mixed.astype(q.dtype)


def latent_attention(c_q, c_kv, k_rope_raw, g_q, g_kv, w_uq, w_ukv, cos, sin):
    B, S, _ = c_q.shape
    q = (rms_norm(c_q, g_q) @ w_uq).reshape(B, S, MLA_HEADS, MLA_NOPE + MLA_ROPE)
    q_nope, q_rope = q[..., :MLA_NOPE], apply_rope(q[..., MLA_NOPE:], cos, sin)
    kv = (rms_norm(c_kv, g_kv) @ w_ukv).reshape(B, S, MLA_HEADS, MLA_NOPE + MLA_V)
    k_nope, v = kv[..., :MLA_NOPE], kv[..., MLA_NOPE:]
    k_rope = apply_rope(k_rope_raw[:, :, None, :], cos, sin)[:, :, 0]
    nb = S // MLA_BLK
    scale = (MLA_NOPE + MLA_ROPE) ** -0.5

    def to_blocks(t):
        return jnp.moveaxis(t.reshape(B, nb, MLA_BLK, MLA_HEADS, t.shape[-1]), 1, 0)

    def one_block(args):
        qn, qr = args
        s = jnp.einsum("bqhd,bkhd->bhqk", qn, k_nope) + jnp.einsum("bqhd,bkd->bhqk", qr, k_rope)
        p = jax.nn.softmax(s.astype(jnp.float32) * scale, axis=-1).astype(v.dtype)
        return jnp.einsum("bhqk,bkhd->bqhd", p, v)

    o = lax.map(one_block, (to_blocks(q_nope), to_blocks(q_rope)))
    return jnp.moveaxis(o, 0, 1).reshape(B, S, MLA_HEADS * MLA_V)


def hybrid_mixer(h, w_in, rpb, t5_table, g_q, g_kv, w_uq, w_ukv, w_out, cos, sin):
    B, S, _ = h.shape
    z = h @ w_in
    bounds = [int(b) for b in np.cumsum([D_A, D_A, D_A, D_B, D_B, D_B, MLA_Q_LORA, MLA_KV_LORA])]
    q_a, k_a, v_a, q_b, k_b, v_b, c_q, c_kv, k_rope_raw = jnp.split(z, bounds, axis=-1)

    def heads(t, n):
        return t.reshape(B, S, n, HEAD_DIM)

    o_a = neighbourhood_attention(heads(q_a, NA_HEADS), heads(k_a, NA_HEADS),
                                  heads(v_a, NA_HEADS), rpb).reshape(B, S, D_A)
    o_b = dilated_attention(heads(q_b, DIL_HEADS), heads(k_b, DIL_HEADS),
                            heads(v_b, DIL_HEADS), t5_table).reshape(B, S, D_B)
    o_c = latent_attention(c_q, c_kv, k_rope_raw, g_q, g_kv, w_uq, w_ukv, cos, sin)
    return jnp.concatenate([o_a, o_b, o_c], axis=-1) @ w_out


def conv_ffn(h, w_up, conv_w, conv_b, w_down):
    S = h.shape[1]
    a, g = jnp.split(h @ w_up, 2, axis=-1)
    pad = CONV_W // 2
    gp = jnp.pad(g, ((0, 0), (pad, pad), (0, 0)))
    gc = conv_b
    for i in range(CONV_W):
        gc = gc + gp[:, i:i + S] * conv_w[i]
    return (jax.nn.gelu(gc) * a) @ w_down


def setup_inputs(seed: int = 0) -> dict:
    key = jax.random.key(seed)
    ks = jax.random.split(key, 20)

    def nrm(k, shape, s):
        return jax.random.normal(k, shape, jnp.float32) * s

    def gain(k, shape):
        return 1.0 + 0.05 * jax.random.normal(k, shape, jnp.float32)

    return {
        "x": nrm(ks[0], (BATCH, SEQ, D_MODEL), 1.0),
        "c": nrm(ks[1], (BATCH, D_MODEL), 1.0),
        "w_ada": nrm(ks[2], (DEPTH, D_MODEL, N_MOD * D_MODEL), 0.5 * D_MODEL ** -0.5),
        "b_ada": nrm(ks[3], (DEPTH, N_MOD * D_MODEL), 0.02),
        "g_pre_mix": gain(ks[4], (DEPTH, D_MODEL)),
        "g_post_mix": gain(ks[5], (DEPTH, D_MODEL)),
        "g_pre_ffn": gain(ks[6], (DEPTH, D_MODEL)),
        "g_post_ffn": gain(ks[7], (DEPTH, D_MODEL)),
        "w_in": nrm(ks[8], (DEPTH, D_MODEL, D_IN), D_MODEL ** -0.5),
        "na_rpb": nrm(ks[9], (DEPTH, NA_HEADS, 2 * NA_KH_MAX - 1, 2 * NA_KW - 1), 0.1),
        "t5_table": nrm(ks[10], (T5_BUCKETS, DIL_HEADS), 0.1),
        "mla_g_q": gain(ks[11], (DEPTH, MLA_Q_LORA)),
        "mla_g_kv": gain(ks[12], (DEPTH, MLA_KV_LORA)),
        "w_uq": nrm(ks[13], (DEPTH, MLA_Q_LORA, MLA_HEADS * (MLA_NOPE + MLA_ROPE)), MLA_Q_LORA ** -0.5),
        "w_ukv": nrm(ks[14], (DEPTH, MLA_KV_LORA, MLA_HEADS * (MLA_NOPE + MLA_V)), MLA_KV_LORA ** -0.5),
        "w_out": nrm(ks[15], (DEPTH, D_MIX, D_MODEL), D_MIX ** -0.5),
        "w_up": nrm(ks[16], (DEPTH, D_MODEL, 2 * D_FF), D_MODEL ** -0.5),
        "conv_w": nrm(ks[17], (DEPTH, CONV_W, D_FF), CONV_W ** -0.5),
        "conv_b": nrm(ks[18], (DEPTH, D_FF), 0.02),
        "w_down": nrm(ks[19], (DEPTH, D_FF, D_MODEL), D_FF ** -0.5),
    }


def reference(x, c, w_ada, b_ada, g_pre_mix, g_post_mix, g_pre_ffn, g_post_ffn, w_in, na_rpb,
              t5_table, mla_g_q, mla_g_kv, w_uq, w_ukv, w_out, w_up, conv_w, conv_b, w_down):
    S = x.shape[1]
    cos, sin = rope_tables(S)
    c_act = jax.nn.silu(c)
    for l in range(DEPTH):
        mod = c_act @ w_ada[l] + b_ada[l]
        sh1, sc1, g1, sh2, sc2, g2 = [m[:, None, :] for m in jnp.split(mod, N_MOD, axis=-1)]
        h = rms_norm(x, g_pre_mix[l]) * (1.0 + sc1) + sh1
        y = hybrid_mixer(h, w_in[l], na_rpb[l], t5_table, mla_g_q[l], mla_g_kv[l],
                         w_uq[l], w_ukv[l], w_out[l], cos, sin)
        x = x + g1 * rms_norm(y, g_post_mix[l])
        h = rms_norm(x, g_pre_ffn[l]) * (1.0 + sc2) + sh2
        y = conv_ffn(h, w_up[l], conv_w[l], conv_b[l], w_down[l])
        x = x + g2 * rms_norm(y, g_post_ffn[l])
    return x
```

```cpp
#include <hip/hip_runtime.h>
#include <hip/hip_cooperative_groups.h>
#include <cstdint>
#include <cstdio>
namespace cg = cooperative_groups;

#define LAS __attribute__((address_space(3)))
typedef unsigned short bf16_t;
typedef short bf16x8 __attribute__((ext_vector_type(8)));
typedef short s16x4 __attribute__((ext_vector_type(4)));
typedef float f32x4 __attribute__((ext_vector_type(4)));
typedef float f32x2 __attribute__((ext_vector_type(2)));
typedef unsigned u32x4 __attribute__((ext_vector_type(4)));
typedef unsigned u32x2 __attribute__((ext_vector_type(2)));
typedef __bf16 bf16x2_t __attribute__((ext_vector_type(2)));

constexpr int DM = 1024, NB = 16, SEQ = 4096, MTOK = NB * SEQ, DEPTH = 4;
constexpr int DIN = 2976, ZLD = 3072, DFF = 2816;
constexpr int ZC_QA = 0, ZC_KA = 256, ZC_VA = 512, ZC_QB = 768, ZC_KB = 1280, ZC_VB = 1792, ZC_CQ = 2304, ZC_CKV = 2688, ZC_KR = 2944;
constexpr float EPS = 1e-6f, LOG2E = 1.4426950408889634f;
constexpr int NTHR = 512, NWAVE = 8;
constexpr int S64 = 160, S96 = 224;

constexpr size_t MiB = 1u << 20;
constexpr size_t WS_MOD = 0;
constexpr size_t WS_BAR = MiB + 768 * 1024;
constexpr size_t WS_ROPE = 2 * MiB;
constexpr size_t WS_RQ = 3 * MiB;
constexpr size_t WS_LUT = 3 * MiB + 512 * 1024;
constexpr size_t WS_LSE = 4 * MiB;
constexpr size_t WS_W = 16 * MiB;
constexpr size_t WL_STRIDE = 26 * MiB;
constexpr size_t WL_IN = 0, WL_OUT = 6 * MiB, WL_UP = 8 * MiB, WL_DOWN = 19 * MiB, WL_UQ = 24 * MiB + 512 * 1024, WL_UKV = 25 * MiB;
constexpr size_t WS_XN = 120 * MiB;
constexpr size_t WS_Z = 248 * MiB;
constexpr size_t WS_Q = 632 * MiB;
constexpr size_t WS_KV = 680 * MiB;
constexpr size_t WS_PART = 744 * MiB;
constexpr size_t WS_G = 248 * MiB;
constexpr size_t WS_HID = 600 * MiB;
constexpr size_t WS_END = 952 * MiB;

__device__ __forceinline__ unsigned pk2(float lo, float hi) { f32x2 v = {lo, hi}; bf16x2_t b = __builtin_convertvector(v, bf16x2_t); return __builtin_bit_cast(unsigned, b); }
__device__ __forceinline__ float bflo(unsigned u) { return __uint_as_float(u << 16); }
__device__ __forceinline__ float bfhi(unsigned u) { return __uint_as_float(u & 0xffff0000u); }
__device__ __forceinline__ float wave_sum(float v) {
#pragma unroll
    for (int o = 1; o < 64; o <<= 1) v += __shfl_xor(v, o);
    return v;
}
__device__ __forceinline__ u32x4 scale_bf8(u32x4 v, float s) {
    u32x4 r;
    r.x = pk2(bflo(v.x) * s, bfhi(v.x) * s); r.y = pk2(bflo(v.y) * s, bfhi(v.y) * s);
    r.z = pk2(bflo(v.z) * s, bfhi(v.z) * s); r.w = pk2(bflo(v.w) * s, bfhi(v.w) * s);
    return r;
}

namespace pg8 {
constexpr int BM = 256, BK = 64, HALF = 128, HTB = HALF * BK * 2, STAGE_BYTES = 8 * HTB, NXCD = 8, WGM = 8;
__device__ __forceinline__ int lds_byte(int r, int c) { const int st = (r >> 4) * 2 + (c >> 5), rr = r & 15, cc = c & 31, ob = rr * 64 + cc * 2; return st * 1024 + (ob ^ (((ob >> 9) & 1) << 5)); }
__device__ __forceinline__ void stage_rc(int b, int& R, int& C) { const int st = b / 1024, sb = b % 1024, swz = sb ^ (((sb >> 9) & 1) << 5); R = (st >> 1) * 16 + swz / 64; C = (st & 1) * 32 + (swz % 64) / 2; }

__device__ __forceinline__ int perm32(int rho) { const int n = rho >> 4, i = rho & 15; return 8 * (i >> 2) + 4 * n + (i & 3); }
struct Unit { int pm, pn; };
struct Gemm { const bf16_t* A; const bf16_t* Bt; int M, N, K, lda; };

struct StaticOrder {
    int nM, nN, nwg, G, c;
    __device__ void init(int M, int N, int G_, int c_) { nM = M / BM; nN = N / BM; nwg = nM * nN; G = G_; c = c_; }
    __device__ bool next(int i, Unit& u) const {
        const long L = (long)i * G + c; if (L >= nwg) return false;
        int wgid = (int)L; { const int q = nwg / NXCD, r = nwg % NXCD, xcd = wgid % NXCD, off = wgid / NXCD; wgid = (xcd < r ? xcd * (q + 1) : r * (q + 1) + (xcd - r) * q) + off; }
        const int nig = WGM * nN, gid = wgid / nig, fm = gid * WGM, gsz = (nM - fm) < WGM ? (nM - fm) : WGM;
        u.pm = fm + ((wgid % nig) % gsz); u.pn = (wgid % nig) / gsz; return true;
    }
};

template <class Epi>
__device__ __forceinline__ void gemm_phase(LAS unsigned char* lds, const Gemm g, const StaticOrder& S, const Epi& E) {
    int tid = threadIdx.x; asm volatile("" : "+v"(tid));
    const int wid = __builtin_amdgcn_readfirstlane(tid >> 6), lane = tid & 63, wr = wid >> 2, wc = wid & 3, fr = lane & 15, fq = lane >> 4;
    const int K = g.K, nt = K / BK, lda = g.lda;
    unsigned voffA[2], voffB[2];
#pragma unroll
    for (int i = 0; i < 2; ++i) { int R, C; stage_rc(tid * 16 + i * 8192, R, C);
        const int Rb = Epi::PERM ? ((R & ~31) + perm32(R & 31)) : R;
        voffA[i] = (unsigned)(R * lda + C) * 2u; voffB[i] = (unsigned)(Rb * K + C) * 2u; }
    const size_t kstep = (size_t)(BK * 2);
    const size_t hstepA = (size_t)HALF * lda * 2, hstepB = (size_t)HALF * K * 2;
    const size_t tstepA = 2 * hstepA, tstepB = 2 * hstepB;
    const unsigned ldsw = (unsigned)wid * 1024u;
    const int aoff = lds_byte(wr * 64 + fr, fq * 8), boff = lds_byte(wc * 32 + fr, fq * 8);
#define PG8_SA(b, h) (((b) * 2 + (h)) * HTB)
#define PG8_SB(b, h) ((4 + (b) * 2 + (h)) * HTB)
#define PG8_STAGE(bufoff, gbase, voff) do { _Pragma("unroll") for (int _i = 0; _i < 2; ++_i) \
        __builtin_amdgcn_global_load_lds((const unsigned*)((const char*)(gbase) + (voff)[_i]), (LAS unsigned*)(lds + (bufoff) + ldsw + _i * 8192), 16, 0, 0); } while (0)
#define PG8_LDA(dst, b, h) do { _Pragma("unroll") for (int m = 0; m < 4; ++m) _Pragma("unroll") for (int k = 0; k < 2; ++k) dst[m][k] = *(const LAS bf16x8*)(lds + PG8_SA(b, h) + aoff + m * 2048 + k * 1024); } while (0)
#define PG8_LDB(dst, b, h) do { _Pragma("unroll") for (int n = 0; n < 2; ++n) _Pragma("unroll") for (int k = 0; k < 2; ++k) dst[n][k] = *(const LAS bf16x8*)(lds + PG8_SB(b, h) + boff + n * 2048 + k * 1024); } while (0)
#define PG8_MMA(ai, bj, At, Bt) do { __builtin_amdgcn_s_setprio(1); _Pragma("unroll") for (int m = 0; m < 4; ++m) _Pragma("unroll") for (int n = 0; n < 2; ++n) _Pragma("unroll") for (int k = 0; k < 2; ++k) \
        acc[ai][bj][m][n] = __builtin_amdgcn_mfma_f32_16x16x32_bf16(Bt[n][k], At[m][k], acc[ai][bj][m][n], 0, 0, 0); __builtin_amdgcn_s_setprio(0); } while (0)
#define PG8_WAIT_V(n) asm volatile("s_waitcnt vmcnt(" #n ")" ::: "memory")
#define PG8_WAIT_L(n) asm volatile("s_waitcnt lgkmcnt(" #n ")" ::: "memory")
#define PG8_BAR __builtin_amdgcn_s_barrier()
#define PG8_SCHED __builtin_amdgcn_sched_barrier(0)
    Unit cur, nxt; int ui = 0;
    if (!S.next(0, cur)) return;
    f32x4 acc[2][2][4][2];
#pragma unroll
    for (int a = 0; a < 2; ++a)
#pragma unroll
        for (int b = 0; b < 2; ++b)
#pragma unroll
            for (int m = 0; m < 4; ++m)
#pragma unroll
                for (int n = 0; n < 2; ++n) acc[a][b][m][n] = (f32x4){0.f, 0.f, 0.f, 0.f};
    bf16x8 At[4][2], B0[2][2], B1[2][2];
    const char* cA = (const char*)g.A + (size_t)cur.pm * tstepA; const char* cB = (const char*)g.Bt + (size_t)cur.pn * tstepB;
    PG8_STAGE(PG8_SB(0, 0), cB, voffB); PG8_STAGE(PG8_SB(0, 1), cB + hstepB, voffB); PG8_STAGE(PG8_SA(0, 0), cA, voffA); PG8_STAGE(PG8_SA(0, 1), cA + hstepA, voffA);
    if (wr == 1) PG8_BAR;
    PG8_WAIT_V(2); PG8_BAR;
    PG8_STAGE(PG8_SB(1, 0), cB + kstep, voffB); PG8_STAGE(PG8_SA(1, 0), cA + kstep, voffA); PG8_STAGE(PG8_SB(1, 1), cB + hstepB + kstep, voffB);
    PG8_WAIT_V(6); PG8_BAR;
    for (;;) {
        const bool has_next = S.next(ui + 1, nxt);
        const char* nA = has_next ? (const char*)g.A + (size_t)nxt.pm * tstepA : cA; const char* nB = has_next ? (const char*)g.Bt + (size_t)nxt.pn * tstepB : cB;
        for (int t = 0; t < nt; t += 2) {
            const bool last = (t == nt - 2);
            const char* a1 = cA + (size_t)(t + 1) * kstep;
            const char* a2 = last ? nA : cA + (size_t)(t + 2) * kstep; const char* b2 = last ? nB : cB + (size_t)(t + 2) * kstep;
            const char* a3 = a2 + kstep; const char* b3 = b2 + kstep;
            PG8_LDB(B0, 0, 0); PG8_LDB(B1, 0, 1); PG8_SCHED; PG8_LDA(At, 0, 0); PG8_STAGE(PG8_SA(1, 1), a1 + hstepA, voffA);
            PG8_WAIT_V(8); PG8_WAIT_L(0); PG8_BAR; PG8_MMA(0, 0, At, B0); PG8_MMA(0, 1, At, B1); PG8_BAR; PG8_SCHED;
            PG8_LDA(At, 0, 1); PG8_STAGE(PG8_SB(0, 0), b2, voffB); PG8_STAGE(PG8_SB(0, 1), b2 + hstepB, voffB); PG8_STAGE(PG8_SA(0, 0), a2, voffA);
            PG8_WAIT_V(8); PG8_WAIT_L(0); PG8_BAR; PG8_MMA(1, 0, At, B0); PG8_MMA(1, 1, At, B1); PG8_BAR; PG8_SCHED;
            PG8_LDB(B0, 1, 0); PG8_LDB(B1, 1, 1); PG8_SCHED; PG8_LDA(At, 1, 0); PG8_STAGE(PG8_SA(0, 1), a2 + hstepA, voffA);
            PG8_WAIT_V(8); PG8_WAIT_L(0); PG8_BAR; PG8_MMA(0, 0, At, B0); PG8_MMA(0, 1, At, B1); PG8_BAR; PG8_SCHED;
            PG8_LDA(At, 1, 1); PG8_STAGE(PG8_SB(1, 0), b3, voffB); PG8_STAGE(PG8_SB(1, 1), b3 + hstepB, voffB); PG8_STAGE(PG8_SA(1, 0), a3, voffA);
            PG8_WAIT_V(8); PG8_WAIT_L(0); PG8_BAR; PG8_MMA(1, 0, At, B0); PG8_MMA(1, 1, At, B1); PG8_BAR; PG8_SCHED;
        }
        if (wr == 0) PG8_BAR;
        E(acc, cur, wr, wc, fr, fq);
        if (!has_next) break;
#pragma unroll
        for (int a = 0; a < 2; ++a)
#pragma unroll
            for (int b = 0; b < 2; ++b)
#pragma unroll
                for (int m = 0; m < 4; ++m)
#pragma unroll
                    for (int n = 0; n < 2; ++n) acc[a][b][m][n] = (f32x4){0.f, 0.f, 0.f, 0.f};
        cur = nxt; cA = nA; cB = nB; ++ui;
        if (wr == 1) PG8_BAR;
    }
    PG8_WAIT_V(0);
    PG8_BAR;
#undef PG8_SA
#undef PG8_SB
#undef PG8_STAGE
#undef PG8_LDA
#undef PG8_LDB
#undef PG8_MMA
#undef PG8_WAIT_V
#undef PG8_WAIT_L
#undef PG8_BAR
#undef PG8_SCHED
}

struct EpiStore16 {
    static constexpr bool PERM = true;
    bf16_t* O; int ldc;
    __device__ __forceinline__ void operator()(const f32x4 (&acc)[2][2][4][2], const Unit& u, int wr, int wc, int fr, int fq) const {
#pragma unroll
        for (int ai = 0; ai < 2; ++ai)
#pragma unroll
            for (int m = 0; m < 4; ++m) {
                bf16_t* rowp = O + (size_t)(u.pm * BM + ai * HALF + wr * 64 + m * 16 + fr) * ldc + u.pn * BM + wc * 32 + 8 * fq;
#pragma unroll
                for (int bj = 0; bj < 2; ++bj) { const f32x4 v0 = acc[ai][bj][m][0], v1 = acc[ai][bj][m][1];
                    u32x4 w; w.x = pk2(v0[0], v0[1]); w.y = pk2(v0[2], v0[3]); w.z = pk2(v1[0], v1[1]); w.w = pk2(v1[2], v1[3]);
                    *(u32x4*)(rowp + bj * HALF) = w; }
            }
    }
};
struct EpiStore {
    static constexpr bool PERM = true;
    bf16_t* O; int ldc; int ncols; int rope_mode; const float* cosT; const float* sinT;
    __device__ __forceinline__ void operator()(const f32x4 (&acc)[2][2][4][2], const Unit& u, int wr, int wc, int fr, int fq) const {
#pragma unroll
        for (int bj = 0; bj < 2; ++bj) {
            const int cg0 = u.pn * BM + bj * HALF + wc * 32;
            if (cg0 >= ncols) continue;
            const bool rope = (rope_mode == 1) ? (cg0 == ZC_KR) : (rope_mode == 2 ? (((cg0 >> 5) % 3) == 2) : false);
#pragma unroll
            for (int ai = 0; ai < 2; ++ai)
#pragma unroll
                for (int m = 0; m < 4; ++m) {
                    const int row = u.pm * BM + ai * HALF + wr * 64 + m * 16 + fr;
                    f32x4 v0 = acc[ai][bj][m][0], v1 = acc[ai][bj][m][1];
                    if (rope) {
                        const int s = row & (SEQ - 1), ib = 8 * (fq & 1);
                        const f32x4 c0 = *(const f32x4*)(cosT + s * 16 + ib), c1 = *(const f32x4*)(cosT + s * 16 + ib + 4);
                        const f32x4 s0 = *(const f32x4*)(sinT + s * 16 + ib), s1 = *(const f32x4*)(sinT + s * 16 + ib + 4);
                        f32x4 p0, p1;
#pragma unroll
                        for (int e = 0; e < 4; ++e) { p0[e] = __shfl_xor(v0[e], 32); p1[e] = __shfl_xor(v1[e], 32); }
                        if (fq < 2) { v0 = v0 * c0 - p0 * s0; v1 = v1 * c1 - p1 * s1; }
                        else        { v0 = p0 * s0 + v0 * c0; v1 = p1 * s1 + v1 * c1; }
                    }
                    u32x4 w; w.x = pk2(v0[0], v0[1]); w.y = pk2(v0[2], v0[3]); w.z = pk2(v1[0], v1[1]); w.w = pk2(v1[2], v1[3]);
                    *(u32x4*)(O + (size_t)row * ldc + cg0 + 8 * fq) = w;
                }
        }
    }
};

struct EpiGate {
    static constexpr bool PERM = true;
    bf16_t* H; const bf16_t* G; const float* cw; const float* cb;
    __device__ __forceinline__ void operator()(const f32x4 (&acc)[2][2][4][2], const Unit& u, int wr, int wc, int fr, int fq) const {
#pragma unroll
        for (int bj = 0; bj < 2; ++bj) {
            const int col = u.pn * BM + bj * HALF + wc * 32 + 8 * fq;
            f32x4 w0[2], w1[2], w2[2], bb[2];
#pragma unroll
            for (int n = 0; n < 2; ++n) { w0[n] = *(const f32x4*)(cw + col + 4 * n); w1[n] = *(const f32x4*)(cw + DFF + col + 4 * n); w2[n] = *(const f32x4*)(cw + 2 * DFF + col + 4 * n); bb[n] = *(const f32x4*)(cb + col + 4 * n); }
#pragma unroll
            for (int ai = 0; ai < 2; ++ai)
#pragma unroll
                for (int m = 0; m < 4; ++m) {
                    const int row = u.pm * BM + ai * HALF + wr * 64 + m * 16 + fr;
                    const int t = row & (SEQ - 1);
                    const bf16_t* gp = G + (size_t)row * DFF + col;
                    const u32x4 z4 = {0u, 0u, 0u, 0u};
                    const u32x4 gm = (t > 0) ? *(const u32x4*)(gp - DFF) : z4;
                    const u32x4 g0 = *(const u32x4*)gp;
                    const u32x4 gn = (t < SEQ - 1) ? *(const u32x4*)(gp + DFF) : z4;
                    unsigned ow[4];
#pragma unroll
                    for (int n = 0; n < 2; ++n) {
                        const unsigned m0 = n ? gm.z : gm.x, m1 = n ? gm.w : gm.y, c0 = n ? g0.z : g0.x, c1 = n ? g0.w : g0.y, n0 = n ? gn.z : gn.x, n1 = n ? gn.w : gn.y;
                        const f32x4 fm = {bflo(m0), bfhi(m0), bflo(m1), bfhi(m1)}, f0 = {bflo(c0), bfhi(c0), bflo(c1), bfhi(c1)}, fn = {bflo(n0), bfhi(n0), bflo(n1), bfhi(n1)};
                        const f32x4 gc = bb[n] + fm * w0[n] + f0 * w1[n] + fn * w2[n];
                        const f32x4 a = acc[ai][bj][m][n];
                        float o[4];
#pragma unroll
                        for (int e = 0; e < 4; ++e) {
                            const float x = gc[e];
                            const float uu = 0.7978845608028654f * (x + 0.044715f * x * x * x);
                            const float ex = __builtin_amdgcn_exp2f(-2.0f * LOG2E * uu);
                            o[e] = x * __builtin_amdgcn_rcpf(1.0f + ex) * a[e];
                        }
                        ow[2 * n] = pk2(o[0], o[1]); ow[2 * n + 1] = pk2(o[2], o[3]);
                    }
                    *(u32x4*)(H + (size_t)row * DFF + col) = (u32x4){ow[0], ow[1], ow[2], ow[3]};
                }
        }
    }
};
}

__device__ __forceinline__ s16x4 vtr(LAS const unsigned char* p) { typedef short v4i16_t __attribute__((ext_vector_type(4))); return __builtin_bit_cast(s16x4, __builtin_amdgcn_ds_read_tr16_b64_v4i16((LAS v4i16_t*)p)); }

template <int NK, int NT, int KSTR, class BM>
__device__ __forceinline__ void attn_step(LAS const unsigned char* Kl, LAS const unsigned char* Vl, int kb, const bf16x8 (&q)[NT][NK], f32x4 (&o)[NT][4], float (&mrun)[NT], float (&lrun)[NT], int lane, const BM& bm) {
    constexpr float THR = 8.0f;
    const int i = lane & 15, g = lane >> 4;
    f32x4 s0[NT], s1[NT];
#pragma unroll
    for (int t = 0; t < NT; ++t) { const float nm = -mrun[t]; s0[t] = (f32x4){nm, nm, nm, nm}; s1[t] = s0[t]; }
    LAS const unsigned char* kp = Kl + (kb + i) * KSTR + g * 16;
#pragma unroll
    for (int ks = 0; ks < NK; ++ks) {
        const bf16x8 a0 = *(LAS const bf16x8*)(kp + ks * 64);
        const bf16x8 a1 = *(LAS const bf16x8*)(kp + 16 * KSTR + ks * 64);
#pragma unroll
        for (int t = 0; t < NT; ++t) {
            s0[t] = __builtin_amdgcn_mfma_f32_16x16x32_bf16(a0, q[t][ks], s0[t], 0, 0, 0);
            s1[t] = __builtin_amdgcn_mfma_f32_16x16x32_bf16(a1, q[t][ks], s1[t], 0, 0, 0);
        }
    }
    bf16x8 pb[NT];
#pragma unroll
    for (int t = 0; t < NT; ++t) {
        bm(s0[t], s1[t], kb, t);
        float mx = fmaxf(fmaxf(fmaxf(s0[t][0], s0[t][1]), fmaxf(s0[t][2], s0[t][3])), fmaxf(fmaxf(s1[t][0], s1[t][1]), fmaxf(s1[t][2], s1[t][3])));
        if (__any(mx > THR)) {
            mx = fmaxf(mx, __shfl_xor(mx, 16)); mx = fmaxf(mx, __shfl_xor(mx, 32));
            const float dl = fmaxf(mx, 0.f);
            const float alpha = __builtin_amdgcn_exp2f(-dl);
            mrun[t] += dl; lrun[t] *= alpha;
#pragma unroll
            for (int db = 0; db < 4; ++db) o[t][db] = o[t][db] * alpha;
            s0[t] = s0[t] - dl; s1[t] = s1[t] - dl;
        }
        float p0[4], p1[4]; float ps = 0.f;
#pragma unroll
        for (int j = 0; j < 4; ++j) { p0[j] = __builtin_amdgcn_exp2f(s0[t][j]); p1[j] = __builtin_amdgcn_exp2f(s1[t][j]); ps += p0[j] + p1[j]; }
        lrun[t] += ps;
        u32x4 w; w.x = pk2(p0[0], p0[1]); w.y = pk2(p0[2], p0[3]); w.z = pk2(p1[0], p1[1]); w.w = pk2(p1[2], p1[3]);
        pb[t] = __builtin_bit_cast(bf16x8, w);
    }
    LAS const unsigned char* vp = Vl + (kb + 4 * g + (i >> 2)) * S64 + (i & 3) * 8;
#pragma unroll
    for (int db = 0; db < 4; ++db) {
        const s16x4 lo = vtr(vp + db * 32), hi = vtr(vp + 16 * S64 + db * 32);
        const bf16x8 va = {lo[0], lo[1], lo[2], lo[3], hi[0], hi[1], hi[2], hi[3]};
#pragma unroll
        for (int t = 0; t < NT; ++t) o[t][db] = __builtin_amdgcn_mfma_f32_16x16x32_bf16(va, pb[t], o[t][db], 0, 0, 0);
    }
}

__device__ __forceinline__ bf16x8 load_q(const bf16_t* p, float s) { const u32x4 v = *(const u32x4*)p; return __builtin_bit_cast(bf16x8, scale_bf8(v, s)); }

struct Params { const float* in[20]; float* out; unsigned char* ws; };
enum { I_X = 0, I_C, I_WADA, I_BADA, I_GPREMIX, I_GPOSTMIX, I_GPREFFN, I_GPOSTFFN, I_WIN, I_RPB, I_T5, I_GQ, I_GKV, I_WUQ, I_WUKV, I_WOUT, I_WUP, I_CONVW, I_CONVB, I_WDOWN };

__device__ const unsigned char T5B[3][65] = {
 {0,1,2,3,4,5,6,7,8,8,8,8,8,8,8,9,9,9,9,9,9,9,9,9,9,9,9,10,10,10,10,10,10,10,10,10,10,10,10,10,10,10,10,10,10,10,10,10,10,10,11,11,11,11,11,11,11,11,11,11,11,11,11,11,11},
 {0,4,8,8,9,9,9,10,10,10,10,10,10,11,11,11,11,11,11,11,11,11,11,12,12,12,12,12,12,12,12,12,12,12,12,12,12,12,12,12,12,12,13,13,13,13,13,13,13,13,13,13,13,13,13,13,13,13,13,13,13,13,13,13,13},
 {0,9,10,10,11,11,12,12,12,12,12,13,13,13,13,13,13,13,13,13,14,14,14,14,14,14,14,14,14,14,14,14,14,14,14,15,15,15,15,15,15,15,15,15,15,15,15,15,15,15,15,15,15,15,15,15,15,15,15,15,15,15,15,15,15}};

__device__ __forceinline__ void transpose_item(const float* W, int K, int N, bf16_t* WT, const float* ksc, LAS float* scr, int item, int lane) {
    const int nblk = N / 32, kb = item / nblk, nb = item % nblk, k0 = 64 * kb, n0 = 32 * nb;
#pragma unroll 8
    for (int i = 0; i < 32; ++i) { const int kk = 2 * i + (lane >> 5); float v = W[(size_t)(k0 + kk) * N + n0 + (lane & 31)]; if (ksc) v *= ksc[k0 + kk]; scr[kk * 33 + (lane & 31)] = v; }
    asm volatile("s_waitcnt lgkmcnt(0)" ::: "memory");
    const int c = lane & 7;
#pragma unroll
    for (int j = 0; j < 4; ++j) { const int n = (lane >> 3) + 8 * j; const LAS float* s = scr + (8 * c) * 33 + n;
        u32x4 o; o.x = pk2(s[0 * 33], s[1 * 33]); o.y = pk2(s[2 * 33], s[3 * 33]); o.z = pk2(s[4 * 33], s[5 * 33]); o.w = pk2(s[6 * 33], s[7 * 33]);
        *(u32x4*)(WT + (size_t)(n0 + n) * K + k0 + 8 * c) = o; }
    asm volatile("s_waitcnt lgkmcnt(0)" ::: "memory");
}

template <int R>
__device__ __forceinline__ void rowwise_rows(int row0, int rstride, const float* xin, const bf16_t* y, const float* gpost, int gate_off, const float* modb, float* xout,
                                             const float* gpre, int sc_off, int sh_off, bf16_t* XN, int lane) {
    f32x4 v[R][4]; u32x2 yw[R][4];
#pragma unroll
    for (int r = 0; r < R; ++r) { const size_t ro = (size_t)(row0 + r * rstride) * DM + 4 * lane;
#pragma unroll
        for (int j = 0; j < 4; ++j) v[r][j] = *(const f32x4*)(xin + ro + 256 * j);
        if (y) {
#pragma unroll
            for (int j = 0; j < 4; ++j) yw[r][j] = *(const u32x2*)(y + ro + 256 * j); } }
#pragma unroll
    for (int r = 0; r < R; ++r) {
        const int row = row0 + r * rstride; const size_t ro = (size_t)row * DM + 4 * lane;
        const float* md = modb + (size_t)(row >> 12) * 6144;
        if (y) {
            f32x4 yv[4]; float ss = 0.f;
#pragma unroll
            for (int j = 0; j < 4; ++j) { const u32x2 w = yw[r][j]; yv[j] = (f32x4){bflo(w.x), bfhi(w.x), bflo(w.y), bfhi(w.y)};
                ss += (yv[j][0] * yv[j][0] + yv[j][1] * yv[j][1]) + (yv[j][2] * yv[j][2] + yv[j][3] * yv[j][3]); }
            const float rr = rsqrtf(wave_sum(ss) * (1.0f / DM) + EPS);
#pragma unroll
            for (int j = 0; j < 4; ++j) { const f32x4 gp = *(const f32x4*)(gpost + 4 * lane + 256 * j), gt = *(const f32x4*)(md + gate_off + 4 * lane + 256 * j);
                v[r][j] = v[r][j] + gt * (yv[j] * rr * gp); }
        }
        if (xout) {
#pragma unroll
            for (int j = 0; j < 4; ++j) *(f32x4*)(xout + ro + 256 * j) = v[r][j];
        }
        if (XN) {
            float ss = 0.f;
#pragma unroll
            for (int j = 0; j < 4; ++j) ss += (v[r][j][0] * v[r][j][0] + v[r][j][1] * v[r][j][1]) + (v[r][j][2] * v[r][j][2] + v[r][j][3] * v[r][j][3]);
            const float rr = rsqrtf(wave_sum(ss) * (1.0f / DM) + EPS);
#pragma unroll
            for (int j = 0; j < 4; ++j) { const f32x4 gp = *(const f32x4*)(gpre + 4 * lane + 256 * j), s1 = *(const f32x4*)(md + sc_off + 4 * lane + 256 * j), s0 = *(const f32x4*)(md + sh_off + 4 * lane + 256 * j);
                const f32x4 h = (v[r][j] * rr * gp) * (s1 + 1.0f) + s0;
                u32x2 w; w.x = pk2(h[0], h[1]); w.y = pk2(h[2], h[3]); *(u32x2*)(XN + ro + 256 * j) = w; }
        }
    }
}

#define XB_TMO      128
#define XB_XCNT(j)  (256  + 64 * (j))
#define XB_XSUB(j)  (1280 + 64 * (j))
#define XB_XGEN(j)  (2304 + 64 * (j))
#define XB_TOP      3328
#define XB_TOPGEN   3392
#define XCD_BAR_WORDS 3456
#define XB_SPIN_CAP (1u << 20)
__device__ __forceinline__ unsigned xb_ld(unsigned* p)              { return __hip_atomic_load(p, __ATOMIC_RELAXED, __HIP_MEMORY_SCOPE_AGENT); }
__device__ __forceinline__ unsigned xb_add(unsigned* p, unsigned v) { return __hip_atomic_fetch_add(p, v, __ATOMIC_RELAXED, __HIP_MEMORY_SCOPE_AGENT); }
__device__ __forceinline__ unsigned xb_xcc_id() { return (unsigned)__builtin_amdgcn_s_getreg((3 << 11) | 20) & 0xFu; }
#define XB_SPIN(cond, bar) do { unsigned _sp = 0; while (cond) { __builtin_amdgcn_s_sleep(1); \
    if ((++_sp & 255u) == 0u) { if (xb_ld(&(bar)[XB_TMO])) break; if (_sp > XB_SPIN_CAP) { atomicAdd(&(bar)[XB_TMO], 1u); break; } } } } while (0)
struct XcdBarrier { unsigned* bar; unsigned x; volatile LAS unsigned* st; };
__device__ __forceinline__ XcdBarrier xcd_barrier_post(unsigned* bar, volatile LAS unsigned* st) {
    XcdBarrier b; b.bar = bar; b.x = xb_xcc_id(); b.st = st;
    if (threadIdx.x == 0) (void)xb_add(&bar[XB_XCNT(b.x)], 1u);
    return b;
}
__device__ __forceinline__ void xcd_barrier_complete(unsigned* bar, unsigned x, unsigned& nloc, unsigned& nx) {
    const unsigned G = gridDim.x * gridDim.y * gridDim.z;
    unsigned sum, cnt, mine, sp = 0u;
    for (;;) {
        sum = 0u; cnt = 0u; mine = 0u;
#pragma unroll
        for (unsigned j = 0; j < 16; ++j) { const unsigned c = xb_ld(&bar[XB_XCNT(j)]); sum += c; cnt += (c > 0u) ? 1u : 0u; mine = (j == x) ? c : mine; }
        if (sum == G) break;
        __builtin_amdgcn_s_sleep(1);
        if ((++sp & 255u) == 0u) { if (xb_ld(&bar[XB_TMO])) break; if (sp > XB_SPIN_CAP) { atomicAdd(&bar[XB_TMO], 1u); break; } }
    }
    nloc = mine > 0u ? mine : 1u; nx = cnt > 0u ? cnt : 1u;
}
__device__ __forceinline__ void xcd_barrier(const XcdBarrier& b) {
    asm volatile("s_waitcnt vmcnt(0)" ::: "memory");
    __syncthreads();
    if (threadIdx.x == 0) {
        unsigned* bar = b.bar; unsigned bx = b.x;
        asm volatile("" : "+s"(bx));
        __builtin_amdgcn_s_waitcnt(0);
        unsigned nloc = b.st[0], nx = b.st[1];
        if (nloc == 0u) { xcd_barrier_complete(bar, bx, nloc, nx); b.st[0] = nloc; b.st[1] = nx; }
        const unsigned old = xb_add(&bar[XB_XSUB(bx)], 1u);
        const unsigned gen = old / nloc;
        if (old + 1u == (gen + 1u) * nloc) {
            __builtin_amdgcn_fence(__ATOMIC_RELEASE, "agent");
            asm volatile("s_waitcnt vmcnt(0)" ::: "memory");
            const unsigned og = xb_add(&bar[XB_TOP], 1u);
            const unsigned tg = og / nx;
            if (og + 1u == (tg + 1u) * nx) xb_add(&bar[XB_TOPGEN], 1u);
            else XB_SPIN(xb_ld(&bar[XB_TOPGEN]) == tg, bar);
            __builtin_amdgcn_fence(__ATOMIC_ACQUIRE, "agent");
            xb_add(&bar[XB_XGEN(bx)], 1u);
            asm volatile("s_waitcnt vmcnt(0)" ::: "memory");
        } else {
            XB_SPIN(xb_ld(&bar[XB_XGEN(bx)]) == gen, bar);
            __builtin_amdgcn_fence(__ATOMIC_ACQUIRE, "agent");
            asm volatile("s_waitcnt vmcnt(0)" ::: "memory");
        }
    }
    __syncthreads();
}

constexpr int LDS_BYTES = 148 * 1024;

__global__ void __launch_bounds__(NTHR, 2) fwd_megakernel(Params P) {
    extern __shared__ __attribute__((aligned(16))) unsigned char lds_raw[];
    LAS unsigned char* lds = (LAS unsigned char*)lds_raw;
    cg::grid_group grid = cg::this_grid();
    volatile LAS unsigned* MISC = (volatile LAS unsigned*)(lds + 3 * 128 * (S96 + S64) + 64);
    if (threadIdx.x < 32) MISC[threadIdx.x] = 0u;
    unsigned* barw = (unsigned*)(P.ws + WS_BAR);
    if (blockIdx.x == 0) for (int i = threadIdx.x; i < XCD_BAR_WORDS; i += NTHR) __hip_atomic_store(barw + i, 0u, __ATOMIC_RELAXED, __HIP_MEMORY_SCOPE_AGENT);
    asm volatile("s_waitcnt vmcnt(0)" ::: "memory");
    __syncthreads();
    grid.sync();
    __builtin_amdgcn_fence(__ATOMIC_ACQUIRE, "agent");
    asm volatile("s_waitcnt vmcnt(0)" ::: "memory");
    const XcdBarrier xbar = xcd_barrier_post(barw, MISC + 8);
#define GSYNC() xcd_barrier(xbar)
    const int G = gridDim.x, bid = blockIdx.x, NGW = G * NWAVE;
#define LOCAL_IDS int tid = threadIdx.x; asm volatile("" : "+v"(tid)); const int lane = tid & 63, wave = __builtin_amdgcn_readfirstlane(tid >> 6), gw = bid * NWAVE + wave; (void)lane; (void)gw;
    unsigned char* ws = P.ws;
    float* modp = (float*)(ws + WS_MOD);
    float* cosT = (float*)(ws + WS_ROPE); float* sinT = cosT + SEQ * 16;
    float* rq = (float*)(ws + WS_RQ); float* rkv = rq + MTOK;
    float* lutg = (float*)(ws + WS_LUT);
    float* lse = (float*)(ws + WS_LSE);
    bf16_t* XN = (bf16_t*)(ws + WS_XN);
    bf16_t* Z = (bf16_t*)(ws + WS_Z);
    bf16_t* QB = (bf16_t*)(ws + WS_Q);
    bf16_t* KVB = (bf16_t*)(ws + WS_KV);
    bf16_t* PART = (bf16_t*)(ws + WS_PART);
    bf16_t* OB = XN;
    bf16_t* YMIX = Z;
    bf16_t* GB = (bf16_t*)(ws + WS_G);
    bf16_t* HID = (bf16_t*)(ws + WS_HID);
    bf16_t* YFFN = XN;

    {
        LOCAL_IDS
        LAS float* scr = (LAS float*)(lds + wave * 16384);
        constexpr int IT_IN = 16 * 93, IT_OUT = 16 * 32, IT_UP = 16 * 176, IT_DOWN = 44 * 32, IT_UQ = 6 * 12, IT_UKV = 4 * 16;
        constexpr int IT_L = IT_IN + IT_OUT + IT_UP + IT_DOWN + IT_UQ + IT_UKV;
        for (int it = gw; it < DEPTH * IT_L; it += NGW) {
            const int l = it / IT_L; int r = it % IT_L;
            unsigned char* wl = ws + WS_W + (size_t)l * WL_STRIDE;
            if (r < IT_IN) { transpose_item(P.in[I_WIN] + (size_t)l * DM * DIN, DM, DIN, (bf16_t*)(wl + WL_IN), nullptr, scr, r, lane); continue; } r -= IT_IN;
            if (r < IT_OUT) { transpose_item(P.in[I_WOUT] + (size_t)l * DM * DM, DM, DM, (bf16_t*)(wl + WL_OUT), nullptr, scr, r, lane); continue; } r -= IT_OUT;
            if (r < IT_UP) { transpose_item(P.in[I_WUP] + (size_t)l * DM * 2 * DFF, DM, 2 * DFF, (bf16_t*)(wl + WL_UP), nullptr, scr, r, lane); continue; } r -= IT_UP;
            if (r < IT_DOWN) { transpose_item(P.in[I_WDOWN] + (size_t)l * DFF * DM, DFF, DM, (bf16_t*)(wl + WL_DOWN), nullptr, scr, r, lane); continue; } r -= IT_DOWN;
            if (r < IT_UQ) { transpose_item(P.in[I_WUQ] + (size_t)l * 384 * 384, 384, 384, (bf16_t*)(wl + WL_UQ), P.in[I_GQ] + l * 384, scr, r, lane); continue; } r -= IT_UQ;
            transpose_item(P.in[I_WUKV] + (size_t)l * 256 * 512, 256, 512, (bf16_t*)(wl + WL_UKV), P.in[I_GKV] + l * 256, scr, r, lane);
        }
        {
            constexpr int PZ_IN = 96 * 1024 / 8, PZ_UQ = 128 * 384 / 8, PZ_L = PZ_IN + PZ_UQ;
            const u32x4 z4 = {0u, 0u, 0u, 0u};
            for (int it = bid * NTHR + tid; it < DEPTH * PZ_L; it += G * NTHR) {
                const int l = it / PZ_L, r = it % PZ_L;
                unsigned char* wl = ws + WS_W + (size_t)l * WL_STRIDE;
                if (r < PZ_IN) *(u32x4*)(wl + WL_IN + (size_t)DIN * DM * 2 + (size_t)r * 16) = z4;
                else *(u32x4*)(wl + WL_UQ + (size_t)384 * 384 * 2 + (size_t)(r - PZ_IN) * 16) = z4;
            }
        }
        for (int it = bid * NTHR + tid; it < SEQ * 16; it += G * NTHR) {
            const int s = it >> 4, i = it & 15;
            const float invf = powf(10000.0f, -(float)(2 * i) / 32.0f);
            const float ang = (float)s * invf;
            const double t = (double)ang * 0.15915494309189535;
            const float fr = (float)(t - floor(t));
            cosT[it] = __builtin_amdgcn_cosf(fr); sinT[it] = __builtin_amdgcn_sinf(fr);
        }
        for (int it = bid * NTHR + tid; it < 3 * 8 * 129; it += G * NTHR) {
            const int p = it / (8 * 129), h = (it / 129) % 8, idx = it % 129, rel = idx - 64, n = rel < 0 ? -rel : rel;
            const int bk = (int)T5B[p][n] + (rel > 0 ? 16 : 0);
            lutg[(p * 8 + h) * 132 + idx] = P.in[I_T5][bk * 8 + h] * LOG2E;
        }
        __syncthreads();
        for (int pair = bid; pair < 96; pair += G) {
            const int l = pair / 24, nc = pair % 24, ks = wave;
#pragma unroll 4
            for (int e = lane; e < 2048; e += 64) { const int b = e >> 7, k = e & 127; const float cv = P.in[I_C][b * DM + ks * 128 + k]; scr[e] = cv / (1.0f + __expf(-cv)); }
            asm volatile("s_waitcnt lgkmcnt(0)" ::: "memory");
            f32x4 accm[16];
#pragma unroll
            for (int b = 0; b < 16; ++b) accm[b] = (f32x4){0.f, 0.f, 0.f, 0.f};
            const float* wp = P.in[I_WADA] + ((size_t)l * DM + ks * 128) * 6144 + nc * 256 + 4 * lane;
#pragma unroll 4
            for (int k = 0; k < 128; ++k) {
                const f32x4 w = *(const f32x4*)(wp + (size_t)k * 6144);
#pragma unroll
                for (int b = 0; b < 16; ++b) accm[b] = accm[b] + w * scr[b * 128 + k];
            }
            asm volatile("s_waitcnt lgkmcnt(0)" ::: "memory");
#pragma unroll
            for (int b = 0; b < 16; ++b) *(LAS f32x4*)(scr + b * 256 + 4 * lane) = accm[b];
            __syncthreads();
            const LAS float* part = (const LAS float*)lds;
#pragma unroll
            for (int j = 0; j < 8; ++j) {
                const int o = tid + NTHR * j, b = o >> 8, n = o & 255;
                float sum = P.in[I_BADA][l * 6144 + nc * 256 + n];
#pragma unroll
                for (int w = 0; w < 8; ++w) sum += part[w * 4096 + o];
                modp[((size_t)l * 16 + b) * 6144 + nc * 256 + n] = sum;
            }
            __syncthreads();
        }
    }
    GSYNC();
    { LOCAL_IDS
    for (int row = gw; row < MTOK; row += 4 * NGW)
        rowwise_rows<4>(row, NGW, P.in[I_X], nullptr, nullptr, 0, modp, nullptr, P.in[I_GPREMIX], 1024, 0, XN, lane);
    }
    GSYNC();

    for (int l = 0; l < DEPTH; ++l) {
        unsigned char* wl = ws + WS_W + (size_t)l * WL_STRIDE;
        const float* modl = modp + (size_t)l * 16 * 6144;
        {
            pg8::Gemm g{XN, (const bf16_t*)(wl + WL_IN), MTOK, ZLD, DM, DM}; pg8::StaticOrder S; S.init(MTOK, ZLD, G, bid);
            pg8::EpiStore E{Z, ZLD, ZLD, 1, cosT, sinT};
            pg8::gemm_phase(lds, g, S, E);
        }
        GSYNC();
        {
            pg8::Gemm g{Z + ZC_CQ, (const bf16_t*)(wl + WL_UQ), MTOK, 512, 384, ZLD}; pg8::StaticOrder S; S.init(MTOK, 512, G, bid);
            pg8::EpiStore E{QB, 384, 384, 2, cosT, sinT};
            pg8::gemm_phase(lds, g, S, E);
        }
        {
            pg8::Gemm g{Z + ZC_CKV, (const bf16_t*)(wl + WL_UKV), MTOK, 512, 256, ZLD}; pg8::StaticOrder S; S.init(MTOK, 512, G, bid);
            pg8::EpiStore16 E{KVB, 512};
            pg8::gemm_phase(lds, g, S, E);
        }
        { LOCAL_IDS
        for (int row0 = gw; row0 < MTOK; row0 += 4 * NGW) {
            u32x4 v0[4], v1[4];
#pragma unroll
            for (int r = 0; r < 4; ++r) { const bf16_t* zr = Z + (size_t)(row0 + r * NGW) * ZLD + ZC_CQ; v0[r] = *(const u32x4*)(zr + 8 * lane);
                v1[r] = (u32x4){0u, 0u, 0u, 0u}; if (lane < 16) v1[r] = *(const u32x4*)(zr + 8 * (lane + 64)); }
#pragma unroll
            for (int r = 0; r < 4; ++r) {
                const u32x4 a = v0[r], c = v1[r];
                const float s0 = bflo(a.x) * bflo(a.x) + bfhi(a.x) * bfhi(a.x) + bflo(a.y) * bflo(a.y) + bfhi(a.y) * bfhi(a.y) + bflo(a.z) * bflo(a.z) + bfhi(a.z) * bfhi(a.z) + bflo(a.w) * bflo(a.w) + bfhi(a.w) * bfhi(a.w);
                const float s1 = bflo(c.x) * bflo(c.x) + bfhi(c.x) * bfhi(c.x) + bflo(c.y) * bflo(c.y) + bfhi(c.y) * bfhi(c.y) + bflo(c.z) * bflo(c.z) + bfhi(c.z) * bfhi(c.z) + bflo(c.w) * bflo(c.w) + bfhi(c.w) * bfhi(c.w);
                float sq = lane < 48 ? s0 : 0.f, sk = (lane < 48 ? 0.f : s0) + s1;
                sq = wave_sum(sq); sk = wave_sum(sk);
                if (lane == 0) { const int row = row0 + r * NGW; rq[row] = rsqrtf(sq * (1.0f / 384.0f) + EPS); rkv[row] = rsqrtf(sk * (1.0f / 256.0f) + EPS); }
            }
        } }
        {
            LOCAL_IDS
            LAS unsigned char* Kl = lds; LAS unsigned char* Vl = lds + 400 * S64; LAS float* biasL = (LAS float*)(lds + 2 * 400 * S64);
            const int i = lane & 15, g4 = lane >> 4, w16 = 16 * wave;
            const int per = (24 * 256 + G - 1) / G, u0 = bid * per, u1 = min(u0 + per, 24 * 256);
            u32x4 pk[6], pvv[6], pq[2][2];
            if (tid < S64) { const u32x4 z4 = {0u, 0u, 0u, 0u}; *(LAS u32x4*)(Kl + 384 * S64 + tid * 16) = z4; *(LAS u32x4*)(Vl + 384 * S64 + tid * 16) = z4; }
            auto decode = [&](int unit, int& p, int& h, int& b, int& r, int& mb, int& dl) {
                const int ph = unit >> 8, rest = unit & 255; p = ph >> 3; h = ph & 7; b = rest >> 4; const int rm = rest & 15;
                dl = 2 * p; const int nmb = 16 >> dl; r = rm / nmb; mb = rm % nmb; };
            auto issue = [&](int unit) {
                int p, h, b, r, mb, dl; decode(unit, p, h, b, r, mb, dl);
                const int L = SEQ >> dl;
                const bf16_t* zb = Z + (size_t)b * SEQ * ZLD + 64 * h;
#pragma unroll
                for (int it = 0; it < 6; ++it) {
                    const int c = tid + NTHR * it, row = c >> 3, ch = c & 7, mk = 256 * mb - 64 + row;
                    pk[it] = (u32x4){0u, 0u, 0u, 0u}; pvv[it] = (u32x4){0u, 0u, 0u, 0u};
                    if (mk >= 0 && mk < L) { const bf16_t* src = zb + (size_t)((mk << dl) + r) * ZLD + 8 * ch; pk[it] = *(const u32x4*)(src + ZC_KB); pvv[it] = *(const u32x4*)(src + ZC_VB); }
                }
#pragma unroll
                for (int t = 0; t < 2; ++t) { const int tq = ((256 * mb + 128 * t + w16 + i) << dl) + r;
                    const bf16_t* qp = zb + (size_t)tq * ZLD + ZC_QB + 8 * g4; pq[t][0] = *(const u32x4*)qp; pq[t][1] = *(const u32x4*)(qp + 32); }
            };
            auto commit = [&]() {
#pragma unroll
                for (int it = 0; it < 6; ++it) { const int c = tid + NTHR * it, row = c >> 3, ch = c & 7;
                    *(LAS u32x4*)(Kl + row * S64 + ch * 16) = pk[it]; *(LAS u32x4*)(Vl + row * S64 + ch * 16) = pvv[it]; }
            };
            int cur_ph = -1;
            issue(min(u0, 24 * 256 - 1));
            for (int unit = u0; unit < u1; ++unit) {
                int p, h, b, r, mb, dl; decode(unit, p, h, b, r, mb, dl);
                const int L = SEQ >> dl, nmb = 16 >> dl;
                commit();
                if ((unit >> 8) != cur_ph) {
                    cur_ph = unit >> 8;
                    const float* lg = lutg + cur_ph * 132;
                    for (int e = tid; e < 2560; e += NTHR) { const int st = e >> 9, ln = (e >> 3) & 63, jj = e & 7;
                        const int rel = 32 * st + 4 * (ln >> 4) + (jj & 3) + 16 * (jj >> 2) - 64 - (ln & 15); const bool ok = (rel >= -64) && (rel <= 64);
                        biasL[e] = ok ? lg[min(max(rel + 64, 0), 128)] : -INFINITY; }
                }
                bf16x8 qf[2][1][2]; f32x4 o[2][1][4]; float mr[2][1], lr[2][1];
#pragma unroll
                for (int t = 0; t < 2; ++t) {
                    qf[t][0][0] = __builtin_bit_cast(bf16x8, scale_bf8(pq[t][0], 0.125f * LOG2E)); qf[t][0][1] = __builtin_bit_cast(bf16x8, scale_bf8(pq[t][1], 0.125f * LOG2E));
                    mr[t][0] = 0.f; lr[t][0] = 0.f;
#pragma unroll
                    for (int db = 0; db < 4; ++db) o[t][0][db] = (f32x4){0.f, 0.f, 0.f, 0.f};
                }
                __syncthreads();
                if (unit + 1 < u1) issue(unit + 1);
                const bool edge = (mb == 0) || (mb == nmb - 1);
#pragma unroll 1
                for (int st = 0; st < 5; ++st) {
                    auto bm = [&](f32x4& s0, f32x4& s1, int kb, int) {
                        const LAS f32x4* bp = (const LAS f32x4*)(biasL + (st * 64 + lane) * 8);
                        s0 = s0 + bp[0]; s1 = s1 + bp[1];
                        if (edge) {
#pragma unroll
                            for (int j = 0; j < 4; ++j) { const int mk0 = 256 * mb - 64 + kb + 4 * g4 + j, mk1 = mk0 + 16;
                                if (mk0 < 0 || mk0 >= L) s0[j] = -INFINITY; if (mk1 < 0 || mk1 >= L) s1[j] = -INFINITY; }
                        }
                    };
#pragma unroll
                    for (int t = 0; t < 2; ++t) attn_step<2, 1, S64>(Kl, Vl, 128 * t + w16 + 32 * st, qf[t], o[t], mr[t], lr[t], lane, bm);
                }
#pragma unroll
                for (int t = 0; t < 2; ++t) {
                    const int tq = ((256 * mb + 128 * t + w16 + i) << dl) + r;
                    float lt = lr[t][0]; lt += __shfl_xor(lt, 16); lt += __shfl_xor(lt, 32);
                    const float inv = 1.0f / lt;
                    bf16_t* op = PART + ((size_t)p * MTOK + (size_t)b * SEQ + tq) * 512 + 64 * h + 4 * g4;
#pragma unroll
                    for (int db = 0; db < 4; ++db) { u32x2 w; w.x = pk2(o[t][0][db][0] * inv, o[t][0][db][1] * inv); w.y = pk2(o[t][0][db][2] * inv, o[t][0][db][3] * inv); *(u32x2*)(op + 16 * db) = w; }
                    if (g4 == 0) lse[((size_t)p * MTOK + (size_t)b * SEQ + tq) * 8 + h] = mr[t][0] + __log2f(lt);
                }
                __syncthreads();
            }
        }
        GSYNC();
        {
            LOCAL_IDS
            constexpr int KB_BYTES = 128 * S96, BUF_BYTES = 128 * S96 + 128 * S64;
            const int i = lane & 15, g4 = lane >> 4;
            const float qscale = 0.10206207261596575f * LOG2E;
            for (int unit = bid; unit < 1024; unit += G) {
                const int b = unit >> 6, h = (unit >> 4) & 3, qb = unit & 15;
                const size_t tb = (size_t)b * SEQ;
                bf16x8 qf[2][3];
#pragma unroll
                for (int t = 0; t < 2; ++t) { const size_t row = tb + qb * 256 + 32 * wave + 16 * t + i; const float sc = rq[row] * qscale;
                    const bf16_t* qp = QB + row * 384 + 96 * h + 8 * g4;
#pragma unroll
                    for (int ks = 0; ks < 3; ++ks) qf[t][ks] = load_q(qp + 32 * ks, sc); }
                f32x4 o[2][4];
#pragma unroll
                for (int t = 0; t < 2; ++t)
#pragma unroll
                    for (int db = 0; db < 4; ++db) o[t][db] = (f32x4){0.f, 0.f, 0.f, 0.f};
                u32x4 pre[5]; unsigned prs;
                auto issue = [&](int c) {
                    int t2 = tid; asm volatile("" : "+v"(t2));
                    const unsigned offKV = (unsigned)(t2 >> 3) * 1024u + (unsigned)(t2 & 7) * 16u, offZ = (unsigned)(t2 >> 2) * (unsigned)(ZLD * 2) + (unsigned)(t2 & 3) * 16u;
                    const size_t key0 = tb + (size_t)c * 128;
                    const char* kvb = (const char*)(KVB + key0 * 512 + 128 * h);
                    pre[0] = *(const u32x4*)(kvb + offKV); pre[1] = *(const u32x4*)(kvb + 65536 + offKV);
                    pre[2] = *(const u32x4*)(kvb + 128 + offKV); pre[3] = *(const u32x4*)(kvb + 128 + 65536 + offKV);
                    pre[4] = *(const u32x4*)((const char*)(Z + key0 * ZLD + ZC_KR) + offZ);
                    prs = pk2(rkv[key0 + (t2 >> 3)], rkv[key0 + 64 + (t2 >> 3)]);
                };
                auto commit = [&](int buf) {
                    int t2 = tid; asm volatile("" : "+v"(t2));
                    const int ldsK = (t2 >> 3) * S96 + (t2 & 7) * 16, ldsV = KB_BYTES + (t2 >> 3) * S64 + (t2 & 7) * 16, ldsR = (t2 >> 2) * S96 + 128 + (t2 & 3) * 16;
                    LAS unsigned char* base = lds + buf * BUF_BYTES;
                    *(LAS u32x4*)(base + ldsK) = scale_bf8(pre[0], bflo(prs)); *(LAS u32x4*)(base + ldsK + 64 * S96) = scale_bf8(pre[1], bfhi(prs));
                    *(LAS u32x4*)(base + ldsV) = scale_bf8(pre[2], bflo(prs)); *(LAS u32x4*)(base + ldsV + 64 * S64) = scale_bf8(pre[3], bfhi(prs));
                    *(LAS u32x4*)(base + ldsR) = pre[4];
                };
                constexpr float THR = 8.0f;
                bf16x8 kf[6]; f32x4 s0[2], s1[2], negm[2], lacc[2];
                const bf16x8 ones = {0x3f80, 0x3f80, 0x3f80, 0x3f80, 0x3f80, 0x3f80, 0x3f80, 0x3f80};
#pragma unroll
                for (int t = 0; t < 2; ++t) { negm[t] = (f32x4){0.f, 0.f, 0.f, 0.f}; lacc[t] = (f32x4){0.f, 0.f, 0.f, 0.f}; }
                auto kload = [&](LAS const unsigned char* Kl, int kb) {
                    LAS const unsigned char* kp = Kl + (kb + i) * S96 + g4 * 16;
#pragma unroll
                    for (int ks = 0; ks < 3; ++ks) { kf[2 * ks] = *(LAS const bf16x8*)(kp + ks * 64); kf[2 * ks + 1] = *(LAS const bf16x8*)(kp + 16 * S96 + ks * 64); }
                };
                auto qkm = [&]() {
#pragma unroll
                    for (int t = 0; t < 2; ++t) {
                        s0[t] = __builtin_amdgcn_mfma_f32_16x16x32_bf16(kf[0], qf[t][0], negm[t], 0, 0, 0);
                        s1[t] = __builtin_amdgcn_mfma_f32_16x16x32_bf16(kf[1], qf[t][0], negm[t], 0, 0, 0);
                    }
#pragma unroll
                    for (int ks = 1; ks < 3; ++ks)
#pragma unroll
                        for (int t = 0; t < 2; ++t) {
                            s0[t] = __builtin_amdgcn_mfma_f32_16x16x32_bf16(kf[2 * ks], qf[t][ks], s0[t], 0, 0, 0);
                            s1[t] = __builtin_amdgcn_mfma_f32_16x16x32_bf16(kf[2 * ks + 1], qf[t][ks], s1[t], 0, 0, 0);
                        }
                };
                auto smpv = [&](LAS const unsigned char* vp) {
                    bf16x8 pb[2];
#pragma unroll
                    for (int t = 0; t < 2; ++t) {
                        float mx = __builtin_fmaxf(__builtin_fmaxf(s0[t][0], s0[t][1]), s0[t][2]);
                        mx = __builtin_fmaxf(__builtin_fmaxf(mx, s0[t][3]), s1[t][0]);
                        mx = __builtin_fmaxf(__builtin_fmaxf(mx, s1[t][1]), s1[t][2]);
                        mx = __builtin_fmaxf(mx, s1[t][3]);
                        if (__any(mx > THR)) {
                            mx = fmaxf(mx, __shfl_xor(mx, 16)); mx = fmaxf(mx, __shfl_xor(mx, 32));
                            const float dl = fmaxf(mx, 0.f);
                            const float alpha = __builtin_amdgcn_exp2f(-dl);
                            negm[t] = negm[t] - dl;
                            lacc[t] = lacc[t] * alpha;
#pragma unroll
                            for (int db = 0; db < 4; ++db) o[t][db] = o[t][db] * alpha;
                            s0[t] = s0[t] - dl; s1[t] = s1[t] - dl;
                        }
                        u32x4 w;
                        w.x = pk2(__builtin_amdgcn_exp2f(s0[t][0]), __builtin_amdgcn_exp2f(s0[t][1])); w.y = pk2(__builtin_amdgcn_exp2f(s0[t][2]), __builtin_amdgcn_exp2f(s0[t][3]));
                        w.z = pk2(__builtin_amdgcn_exp2f(s1[t][0]), __builtin_amdgcn_exp2f(s1[t][1])); w.w = pk2(__builtin_amdgcn_exp2f(s1[t][2]), __builtin_amdgcn_exp2f(s1[t][3]));
                        pb[t] = __builtin_bit_cast(bf16x8, w);
                    }
#pragma unroll
                    for (int t = 0; t < 2; ++t) lacc[t] = __builtin_amdgcn_mfma_f32_16x16x32_bf16(ones, pb[t], lacc[t], 0, 0, 0);
#pragma unroll
                    for (int db = 0; db < 4; ++db) {
                        const s16x4 lo = vtr(vp + db * 32), hi = vtr(vp + 16 * S64 + db * 32);
                        const bf16x8 va = {lo[0], lo[1], lo[2], lo[3], hi[0], hi[1], hi[2], hi[3]};
#pragma unroll
                        for (int t = 0; t < 2; ++t) o[t][db] = __builtin_amdgcn_mfma_f32_16x16x32_bf16(va, pb[t], o[t][db], 0, 0, 0);
                    }
                };
#define MLA_VP(VL, KBV) ((VL) + ((KBV) + 4 * g4 + (i >> 2)) * S64 + (i & 3) * 8)
#define MLA_STEP(KLN, KBN, VL, KBV) do { kload(KLN, KBN); __builtin_amdgcn_sched_barrier(0); smpv(MLA_VP(VL, KBV)); qkm(); __builtin_amdgcn_sched_barrier(0); } while (0)
                issue(0); commit(0); issue(1);
                __syncthreads();
                kload(lds, 0); qkm();
                int bc = 0;
                for (int c = 0; c < 32; ++c) {
                    const int bn = (bc == 2) ? 0 : bc + 1;
                    if (c + 1 < 32) commit(bn);
                    if (c + 2 < 32) issue(c + 2);
                    LAS const unsigned char* Kl = lds + bc * BUF_BYTES; LAS const unsigned char* Vl = Kl + KB_BYTES;
                    MLA_STEP(Kl, 32, Vl, 0);
                    MLA_STEP(Kl, 64, Vl, 32);
                    MLA_STEP(Kl, 96, Vl, 64);
                    __syncthreads();
                    if (c + 1 < 32) { MLA_STEP(lds + bn * BUF_BYTES, 0, Vl, 96); }
                    else { smpv(MLA_VP(Vl, 96)); }
                    bc = bn;
                }
#undef MLA_STEP
#undef MLA_VP
                __syncthreads();
#pragma unroll
                for (int t = 0; t < 2; ++t) {
                    const float inv = 1.0f / lacc[t][0];
                    bf16_t* op = OB + (tb + qb * 256 + 32 * wave + 16 * t + i) * DM + 768 + 64 * h + 4 * g4;
#pragma unroll
                    for (int db = 0; db < 4; ++db) { u32x2 w; w.x = pk2(o[t][db][0] * inv, o[t][db][1] * inv); w.y = pk2(o[t][db][2] * inv, o[t][db][3] * inv); *(u32x2*)(op + 16 * db) = w; }
                }
            }
        }
        {
            LOCAL_IDS
            LAS unsigned char* Kl = lds; LAS unsigned char* Vl = lds + 2 * 128 * S64; LAS float* lutl = (LAS float*)(lds + 4 * 128 * S64);
            const int i = lane & 15, g4 = lane >> 4, hh = wave >> 2, ct = wave & 3;
            const int cbase = ct == 0 ? 0 : (ct == 1 ? 8 : (ct == 2 ? 24 : 32));
            const float* rpb = P.in[I_RPB] + (size_t)l * 4 * 465;
            for (int e = tid; e < 1860; e += NTHR) lutl[e] = rpb[e] * LOG2E;
            int bid2 = bid; asm volatile("" : "+s"(bid2));
            const int per = (2048 + G - 1) / G, u0 = min(bid2 * per, 2047), u1 = min(bid2 * per + per, 2048), nf = (u1 - u0) * 4;
            const int qc = 16 * ct + i, cs = min(max(qc - 8, 0), 48);
            u32x4 pk[4], pvv[4], pq[2];
            auto issue = [&](int f) {
                const int unit = u0 + (f >> 2), c = f & 3, b = unit >> 7, rr = (unit >> 1) & 63, hp = unit & 1;
                const int r0 = min(max(rr - 4, 0), 56), tk0 = (r0 + 2 * c) * 64;
                const bf16_t* zb = Z + (size_t)b * SEQ * ZLD;
#pragma unroll
                for (int it = 0; it < 4; ++it) {
                    const int e = tid + NTHR * it, h2 = e >> 10, row = (e >> 3) & 127, ch = e & 7;
                    const bf16_t* src = zb + (size_t)(tk0 + row) * ZLD + 64 * (2 * hp + h2) + 8 * ch;
                    pk[it] = *(const u32x4*)(src + ZC_KA); pvv[it] = *(const u32x4*)(src + ZC_VA);
                }
                if (c == 0) { const bf16_t* qp = zb + (size_t)(rr * 64 + qc) * ZLD + ZC_QA + 64 * (2 * hp + hh) + 8 * g4; pq[0] = *(const u32x4*)qp; pq[1] = *(const u32x4*)(qp + 32); }
            };
            auto commit = [&]() {
#pragma unroll
                for (int it = 0; it < 4; ++it) { const int e = tid + NTHR * it, h2 = e >> 10, row = (e >> 3) & 127, ch = e & 7;
                    *(LAS u32x4*)(Kl + (h2 * 128 + row) * S64 + ch * 16) = pk[it]; *(LAS u32x4*)(Vl + (h2 * 128 + row) * S64 + ch * 16) = pvv[it]; }
            };
            bf16x8 qf[1][2]; f32x4 o[1][4]; float mr[1] = {0.f}, lr[1] = {0.f};
            qf[0][0] = (bf16x8){0, 0, 0, 0, 0, 0, 0, 0}; qf[0][1] = qf[0][0];
#pragma unroll
            for (int db = 0; db < 4; ++db) o[0][db] = (f32x4){0.f, 0.f, 0.f, 0.f};
            issue(0);
            for (int f = 0; f < nf; ++f) {
                const int unit = u0 + (f >> 2), c = f & 3, b = unit >> 7, rr = (unit >> 1) & 63, hp = unit & 1, head = 2 * hp + hh;
                const int r0 = min(max(rr - 4, 0), 56);
                commit();
                if (c == 0) {
                    qf[0][0] = __builtin_bit_cast(bf16x8, scale_bf8(pq[0], 0.125f * LOG2E)); qf[0][1] = __builtin_bit_cast(bf16x8, scale_bf8(pq[1], 0.125f * LOG2E));
                    mr[0] = 0.f; lr[0] = 0.f;
#pragma unroll
                    for (int db = 0; db < 4; ++db) o[0][db] = (f32x4){0.f, 0.f, 0.f, 0.f};
                }
                __syncthreads();
                if (f + 1 < nf) issue(f + 1);
#pragma unroll
                for (int kr = 0; kr < 2; ++kr) {
                    const int dr = (r0 + 2 * c + kr) - rr + 7;
                    const LAS float* lrow = lutl + head * 465 + dr * 31;
                    auto bm = [&](f32x4& s0, f32x4& s1, int, int) {
#pragma unroll
                        for (int j = 0; j < 4; ++j) {
                            { const int kc = cbase + 4 * g4 + j; const bool ok = (kc >= cs) && (kc < cs + 16); const int idx = min(max(kc - qc + 15, 0), 30);
                              s0[j] = ok ? s0[j] + lrow[idx] : -INFINITY; }
                            { const int kc = cbase + 16 + 4 * g4 + j; const bool ok = (kc >= cs) && (kc < cs + 16); const int idx = min(max(kc - qc + 15, 0), 30);
                              s1[j] = ok ? s1[j] + lrow[idx] : -INFINITY; }
                        }
                    };
                    attn_step<2, 1, S64>(Kl + hh * 128 * S64, Vl + hh * 128 * S64, kr * 64 + cbase, qf, o, mr, lr, lane, bm);
                }
                if (c == 3) {
                    float lt = lr[0]; lt += __shfl_xor(lt, 16); lt += __shfl_xor(lt, 32);
                    const float inv = 1.0f / lt;
                    bf16_t* op = OB + ((size_t)b * SEQ + rr * 64 + qc) * DM + 64 * head + 4 * g4;
#pragma unroll
                    for (int db = 0; db < 4; ++db) { u32x2 w; w.x = pk2(o[0][db][0] * inv, o[0][db][1] * inv); w.y = pk2(o[0][db][2] * inv, o[0][db][3] * inv); *(u32x2*)(op + 16 * db) = w; }
                }
                __syncthreads();
            }
        }
        { LOCAL_IDS
        const int h = lane >> 3;
        for (int row0 = gw; row0 < MTOK; row0 += 4 * NGW) {
            u32x4 pa[4], pb_[4], pc[4]; float l0[4], l1[4], l2[4];
#pragma unroll
            for (int r = 0; r < 4; ++r) { const size_t row = (size_t)(row0 + r * NGW);
                l0[r] = lse[((size_t)0 * MTOK + row) * 8 + h]; l1[r] = lse[((size_t)1 * MTOK + row) * 8 + h]; l2[r] = lse[((size_t)2 * MTOK + row) * 8 + h];
                pa[r] = *(const u32x4*)(PART + ((size_t)0 * MTOK + row) * 512 + 8 * lane);
                pb_[r] = *(const u32x4*)(PART + ((size_t)1 * MTOK + row) * 512 + 8 * lane);
                pc[r] = *(const u32x4*)(PART + ((size_t)2 * MTOK + row) * 512 + 8 * lane); }
#pragma unroll
            for (int r = 0; r < 4; ++r) {
                const float mx = fmaxf(l0[r], fmaxf(l1[r], l2[r]));
                float w0 = __builtin_amdgcn_exp2f(l0[r] - mx), w1 = __builtin_amdgcn_exp2f(l1[r] - mx), w2 = __builtin_amdgcn_exp2f(l2[r] - mx);
                const float inv = 1.0f / (w0 + w1 + w2); w0 *= inv; w1 *= inv; w2 *= inv;
                const u32x4 a = pa[r], bq = pb_[r], cq = pc[r];
                u32x4 o;
                o.x = pk2(w0 * bflo(a.x) + w1 * bflo(bq.x) + w2 * bflo(cq.x), w0 * bfhi(a.x) + w1 * bfhi(bq.x) + w2 * bfhi(cq.x));
                o.y = pk2(w0 * bflo(a.y) + w1 * bflo(bq.y) + w2 * bflo(cq.y), w0 * bfhi(a.y) + w1 * bfhi(bq.y) + w2 * bfhi(cq.y));
                o.z = pk2(w0 * bflo(a.z) + w1 * bflo(bq.z) + w2 * bflo(cq.z), w0 * bfhi(a.z) + w1 * bfhi(bq.z) + w2 * bfhi(cq.z));
                o.w = pk2(w0 * bflo(a.w) + w1 * bflo(bq.w) + w2 * bflo(cq.w), w0 * bfhi(a.w) + w1 * bfhi(bq.w) + w2 * bfhi(cq.w));
                *(u32x4*)(OB + (size_t)(row0 + r * NGW) * DM + 256 + 8 * lane) = o;
            }
        } }
        GSYNC();
        {
            pg8::Gemm g{OB, (const bf16_t*)(wl + WL_OUT), MTOK, DM, DM, DM}; pg8::StaticOrder S; S.init(MTOK, DM, G, bid);
            pg8::EpiStore16 E{YMIX, DM};
            pg8::gemm_phase(lds, g, S, E);
        }
        GSYNC();
        { LOCAL_IDS
        for (int row = gw; row < MTOK; row += 4 * NGW)
            rowwise_rows<4>(row, NGW, (l == 0 ? P.in[I_X] : P.out), YMIX, P.in[I_GPOSTMIX] + l * DM, 2048, modl, P.out, P.in[I_GPREFFN] + l * DM, 4096, 3072, XN, lane);
        }
        GSYNC();
        {
            pg8::Gemm g{XN, (const bf16_t*)(wl + WL_UP) + (size_t)DFF * DM, MTOK, DFF, DM, DM}; pg8::StaticOrder S; S.init(MTOK, DFF, G, bid);
            pg8::EpiStore16 E{GB, DFF};
            pg8::gemm_phase(lds, g, S, E);
        }
        GSYNC();
        {
            pg8::Gemm g{XN, (const bf16_t*)(wl + WL_UP), MTOK, DFF, DM, DM}; pg8::StaticOrder S; S.init(MTOK, DFF, G, bid);
            pg8::EpiGate E{HID, GB, P.in[I_CONVW] + (size_t)l * 3 * DFF, P.in[I_CONVB] + (size_t)l * DFF};
            pg8::gemm_phase(lds, g, S, E);
        }
        GSYNC();
        {
            pg8::Gemm g{HID, (const bf16_t*)(wl + WL_DOWN), MTOK, DM, DFF, DFF}; pg8::StaticOrder S; S.init(MTOK, DM, G, bid);
            pg8::EpiStore16 E{YFFN, DM};
            pg8::gemm_phase(lds, g, S, E);
        }
        GSYNC();
        { LOCAL_IDS
        const int ln = (l + 1 < DEPTH) ? l + 1 : l;
        for (int row = gw; row < MTOK; row += 4 * NGW)
            rowwise_rows<4>(row, NGW, P.out, YFFN, P.in[I_GPOSTFFN] + l * DM, 5120, modl, P.out, P.in[I_GPREMIX] + ln * DM, (ln - l) * 16 * 6144 + 1024, (ln - l) * 16 * 6144, (l + 1 < DEPTH) ? XN : nullptr, lane);
        }
        if (l + 1 < DEPTH) GSYNC();
    }
}

extern "C" void kernel_launch(void* const* d_in, const int* in_sizes, int n_in, void* d_out, int out_size, void* d_ws, size_t ws_size, hipStream_t stream) {
    static int grid_blocks = 0;
    if (grid_blocks == 0) {
        if (n_in != 20 || ws_size < WS_END) { fprintf(stderr, "kernel_launch: unexpected n_in %d or ws_size %zu\n", n_in, ws_size); grid_blocks = -1; return; }
        int dev = 0, cus = 0, per_cu = 0;
        hipGetDevice(&dev);
        hipDeviceGetAttribute(&cus, hipDeviceAttributeMultiprocessorCount, dev);
        if (hipFuncSetAttribute((const void*)fwd_megakernel, hipFuncAttributeMaxDynamicSharedMemorySize, LDS_BYTES) != hipSuccess) fprintf(stderr, "kernel_launch: hipFuncSetAttribute failed\n");
        hipOccupancyMaxActiveBlocksPerMultiprocessor(&per_cu, (const void*)fwd_megakernel, NTHR, LDS_BYTES);
        (void)hipGetLastError();
        if (per_cu < 1) { fprintf(stderr, "kernel_launch: occupancy query gives %d\n", per_cu); per_cu = 1; }
        grid_blocks = cus;
    }
    if (grid_blocks < 0) return;
    Params p{};
    for (int i = 0; i < 20; ++i) p.in[i] = (const float*)d_in[i];
    p.out = (float*)d_out; p.ws = (unsigned char*)d_ws;
    void* args[] = {&p};
    hipError_t e = hipLaunchCooperativeKernel((const void*)fwd_megakernel, dim3(grid_blocks), dim3(NTHR), args, LDS_BYTES, stream);
    if (e != hipSuccess) fprintf(stderr, "cooperative launch failed: %s (grid %d)\n", hipGetErrorString(e), grid_blocks);
}
```

```cpp
#include <hip/hip_runtime.h>
#include <hip/hip_cooperative_groups.h>
#include <cstdint>
#include <cstdio>
namespace cg = cooperative_groups;

#define LAS __attribute__((address_space(3)))
typedef unsigned short bf16_t;
typedef short bf16x8 __attribute__((ext_vector_type(8)));
typedef short s16x4 __attribute__((ext_vector_type(4)));
typedef float f32x4 __attribute__((ext_vector_type(4)));
typedef float f32x2 __attribute__((ext_vector_type(2)));
typedef unsigned u32x4 __attribute__((ext_vector_type(4)));
typedef unsigned u32x2 __attribute__((ext_vector_type(2)));
typedef __bf16 bf16x2_t __attribute__((ext_vector_type(2)));

constexpr int DM = 1024, NB = 16, SEQ = 4096, MTOK = NB * SEQ, DEPTH = 4;
constexpr int DIN = 2976, ZLD = 3072, DFF = 2816;
constexpr int ZC_QA = 0, ZC_KA = 256, ZC_VA = 512, ZC_QB = 768, ZC_KB = 1280, ZC_VB = 1792, ZC_CQ = 2304, ZC_CKV = 2688, ZC_KR = 2944;
constexpr float EPS = 1e-6f, LOG2E = 1.4426950408889634f;
constexpr int NTHR = 512, NWAVE = 8;
constexpr int S64 = 160, S96 = 224;

constexpr size_t MiB = 1u << 20;
constexpr size_t WS_MOD = 0;
constexpr size_t WS_BAR = MiB + 768 * 1024;
constexpr size_t WS_ROPE = 2 * MiB;
constexpr size_t WS_RQ = 3 * MiB;
constexpr size_t WS_LUT = 3 * MiB + 512 * 1024;
constexpr size_t WS_LSE = 4 * MiB;
constexpr size_t WS_W = 16 * MiB;
constexpr size_t WL_STRIDE = 26 * MiB;
constexpr size_t WL_IN = 0, WL_OUT = 6 * MiB, WL_UP = 8 * MiB, WL_DOWN = 19 * MiB, WL_UQ = 24 * MiB + 512 * 1024, WL_UKV = 25 * MiB;
constexpr size_t WS_XN = 120 * MiB;
constexpr size_t WS_Z = 248 * MiB;
constexpr size_t WS_Q = 632 * MiB;
constexpr size_t WS_KV = 680 * MiB;
constexpr size_t WS_PART = 744 * MiB;
constexpr size_t WS_G = 248 * MiB;
constexpr size_t WS_HID = 600 * MiB;
constexpr size_t WS_END = 952 * MiB;

__device__ __forceinline__ unsigned pk2(float lo, float hi) { f32x2 v = {lo, hi}; bf16x2_t b = __builtin_convertvector(v, bf16x2_t); return __builtin_bit_cast(unsigned, b); }
__device__ __forceinline__ float bflo(unsigned u) { return __uint_as_float(u << 16); }
__device__ __forceinline__ float bfhi(unsigned u) { return __uint_as_float(u & 0xffff0000u); }
__device__ __forceinline__ float wave_sum(float v) {
#pragma unroll
    for (int o = 1; o < 64; o <<= 1) v += __shfl_xor(v, o);
    return v;
}
__device__ __forceinline__ u32x4 scale_bf8(u32x4 v, float s) {
    u32x4 r;
    r.x = pk2(bflo(v.x) * s, bfhi(v.x) * s); r.y = pk2(bflo(v.y) * s, bfhi(v.y) * s);
    r.z = pk2(bflo(v.z) * s, bfhi(v.z) * s); r.w = pk2(bflo(v.w) * s, bfhi(v.w) * s);
    return r;
}

namespace pg8 {
constexpr int BM = 256, BK = 64, HALF = 128, HTB = HALF * BK * 2, STAGE_BYTES = 8 * HTB, NXCD = 8, WGM = 8;
__device__ __forceinline__ int lds_byte(int r, int c) { const int st = (r >> 4) * 2 + (c >> 5), rr = r & 15, cc = c & 31, ob = rr * 64 + cc * 2; return st * 1024 + (ob ^ (((ob >> 9) & 1) << 5)); }
__device__ __forceinline__ void stage_rc(int b, int& R, int& C) { const int st = b / 1024, sb = b % 1024, swz = sb ^ (((sb >> 9) & 1) << 5); R = (st >> 1) * 16 + swz / 64; C = (st & 1) * 32 + (swz % 64) / 2; }

__device__ __forceinline__ int perm32(int rho) { const int n = rho >> 4, i = rho & 15; return 8 * (i >> 2) + 4 * n + (i & 3); }
struct Unit { int pm, pn; };
struct Gemm { const bf16_t* A; const bf16_t* Bt; int M, N, K, lda; };

struct StaticOrder {
    int nM, nN, nwg, G, c;
    __device__ void init(int M, int N, int G_, int c_) { nM = M / BM; nN = N / BM; nwg = nM * nN; G = G_; c = c_; }
    __device__ bool next(int i, Unit& u) const {
        const long L = (long)i * G + c; if (L >= nwg) return false;
        int wgid = (int)L; { const int q = nwg / NXCD, r = nwg % NXCD, xcd = wgid % NXCD, off = wgid / NXCD; wgid = (xcd < r ? xcd * (q + 1) : r * (q + 1) + (xcd - r) * q) + off; }
        const int nig = WGM * nN, gid = wgid / nig, fm = gid * WGM, gsz = (nM - fm) < WGM ? (nM - fm) : WGM;
        u.pm = fm + ((wgid % nig) % gsz); u.pn = (wgid % nig) / gsz; return true;
    }
};

template <class Epi>
__device__ __forceinline__ void gemm_phase(LAS unsigned char* lds, const Gemm g, const StaticOrder& S, const Epi& E) {
    int tid = threadIdx.x; asm volatile("" : "+v"(tid));
    const int wid = __builtin_amdgcn_readfirstlane(tid >> 6), lane = tid & 63, wr = wid >> 2, wc = wid & 3, fr = lane & 15, fq = lane >> 4;
    const int K = g.K, nt = K / BK, lda = g.lda;
    unsigned voffA[2], voffB[2];
#pragma unroll
    for (int i = 0; i < 2; ++i) { int R, C; stage_rc(tid * 16 + i * 8192, R, C);
        const int Rb = Epi::PERM ? ((R & ~31) + perm32(R & 31)) : R;
        voffA[i] = (unsigned)(R * lda + C) * 2u; voffB[i] = (unsigned)(Rb * K + C) * 2u; }
    const size_t kstep = (size_t)(BK * 2);
    const size_t hstepA = (size_t)HALF * lda * 2, hstepB = (size_t)HALF * K * 2;
    const size_t tstepA = 2 * hstepA, tstepB = 2 * hstepB;
    const unsigned ldsw = (unsigned)wid * 1024u;
    const int aoff = lds_byte(wr * 64 + fr, fq * 8), boff = lds_byte(wc * 32 + fr, fq * 8);
#define PG8_SA(b, h) (((b) * 2 + (h)) * HTB)
#define PG8_SB(b, h) ((4 + (b) * 2 + (h)) * HTB)
#define PG8_STAGE(bufoff, gbase, voff) do { _Pragma("unroll") for (int _i = 0; _i < 2; ++_i) \
        __builtin_amdgcn_global_load_lds((const unsigned*)((const char*)(gbase) + (voff)[_i]), (LAS unsigned*)(lds + (bufoff) + ldsw + _i * 8192), 16, 0, 0); } while (0)
#define PG8_LDA(dst, b, h) do { _Pragma("unroll") for (int m = 0; m < 4; ++m) _Pragma("unroll") for (int k = 0; k < 2; ++k) dst[m][k] = *(const LAS bf16x8*)(lds + PG8_SA(b, h) + aoff + m * 2048 + k * 1024); } while (0)
#define PG8_LDB(dst, b, h) do { _Pragma("unroll") for (int n = 0; n < 2; ++n) _Pragma("unroll") for (int k = 0; k < 2; ++k) dst[n][k] = *(const LAS bf16x8*)(lds + PG8_SB(b, h) + boff + n * 2048 + k * 1024); } while (0)
#define PG8_MMA(ai, bj, At, Bt) do { __builtin_amdgcn_s_setprio(1); _Pragma("unroll") for (int m = 0; m < 4; ++m) _Pragma("unroll") for (int n = 0; n < 2; ++n) _Pragma("unroll") for (int k = 0; k < 2; ++k) \
        acc[ai][bj][m][n] = __builtin_amdgcn_mfma_f32_16x16x32_bf16(Bt[n][k], At[m][k], acc[ai][bj][m][n], 0, 0, 0); __builtin_amdgcn_s_setprio(0); } while (0)
#define PG8_WAIT_V(n) asm volatile("s_waitcnt vmcnt(" #n ")" ::: "memory")
#define PG8_WAIT_L(n) asm volatile("s_waitcnt lgkmcnt(" #n ")" ::: "memory")
#define PG8_BAR __builtin_amdgcn_s_barrier()
#define PG8_SCHED __builtin_amdgcn_sched_barrier(0)
    Unit cur, nxt; int ui = 0;
    if (!S.next(0, cur)) return;
    f32x4 acc[2][2][4][2];
#pragma unroll
    for (int a = 0; a < 2; ++a)
#pragma unroll
        for (int b = 0; b < 2; ++b)
#pragma unroll
            for (int m = 0; m < 4; ++m)
#pragma unroll
                for (int n = 0; n < 2; ++n) acc[a][b][m][n] = (f32x4){0.f, 0.f, 0.f, 0.f};
    bf16x8 At[4][2], B0[2][2], B1[2][2];
    const char* cA = (const char*)g.A + (size_t)cur.pm * tstepA; const char* cB = (const char*)g.Bt + (size_t)cur.pn * tstepB;
    PG8_STAGE(PG8_SB(0, 0), cB, voffB); PG8_STAGE(PG8_SB(0, 1), cB + hstepB, voffB); PG8_STAGE(PG8_SA(0, 0), cA, voffA); PG8_STAGE(PG8_SA(0, 1), cA + hstepA, voffA);
    if (wr == 1) PG8_BAR;
    PG8_WAIT_V(2); PG8_BAR;
    PG8_STAGE(PG8_SB(1, 0), cB + kstep, voffB); PG8_STAGE(PG8_SA(1, 0), cA + kstep, voffA); PG8_STAGE(PG8_SB(1, 1), cB + hstepB + kstep, voffB);
    PG8_WAIT_V(6); PG8_BAR;
    for (;;) {
        const bool has_next = S.next(ui + 1, nxt);
        const char* nA = has_next ? (const char*)g.A + (size_t)nxt.pm * tstepA : cA; const char* nB = has_next ? (const char*)g.Bt + (size_t)nxt.pn * tstepB : cB;
        for (int t = 0; t < nt; t += 2) {
            const bool last = (t == nt - 2);
            const char* a1 = cA + (size_t)(t + 1) * kstep;
            const char* a2 = last ? nA : cA + (size_t)(t + 2) * kstep; const char* b2 = last ? nB : cB + (size_t)(t + 2) * kstep;
            const char* a3 = a2 + kstep; const char* b3 = b2 + kstep;
            PG8_LDB(B0, 0, 0); PG8_LDB(B1, 0, 1); PG8_SCHED; PG8_LDA(At, 0, 0); PG8_STAGE(PG8_SA(1, 1), a1 + hstepA, voffA);
            PG8_WAIT_V(8); PG8_WAIT_L(0); PG8_BAR; PG8_MMA(0, 0, At, B0); PG8_MMA(0, 1, At, B1); PG8_BAR; PG8_SCHED;
            PG8_LDA(At, 0, 1); PG8_STAGE(PG8_SB(0, 0), b2, voffB); PG8_STAGE(PG8_SB(0, 1), b2 + hstepB, voffB); PG8_STAGE(PG8_SA(0, 0), a2, voffA);
            PG8_WAIT_V(8); PG8_WAIT_L(0); PG8_BAR; PG8_MMA(1, 0, At, B0); PG8_MMA(1, 1, At, B1); PG8_BAR; PG8_SCHED;
            PG8_LDB(B0, 1, 0); PG8_LDB(B1, 1, 1); PG8_SCHED; PG8_LDA(At, 1, 0); PG8_STAGE(PG8_SA(0, 1), a2 + hstepA, voffA);
            PG8_WAIT_V(8); PG8_WAIT_L(0); PG8_BAR; PG8_MMA(0, 0, At, B0); PG8_MMA(0, 1, At, B1); PG8_BAR; PG8_SCHED;
            PG8_LDA(At, 1, 1); PG8_STAGE(PG8_SB(1, 0), b3, voffB); PG8_STAGE(PG8_SB(1, 1), b3 + hstepB, voffB); PG8_STAGE(PG8_SA(1, 0), a3, voffA);
            PG8_WAIT_V(8); PG8_WAIT_L(0); PG8_BAR; PG8_MMA(1, 0, At, B0); PG8_MMA(1, 1, At, B1); PG8_BAR; PG8_SCHED;
        }
        if (wr == 0) PG8_BAR;
        E(acc, cur, wr, wc, fr, fq);
        if (!has_next) break;
#pragma unroll
        for (int a = 0; a < 2; ++a)
#pragma unroll
            for (int b = 0; b < 2; ++b)
#pragma unroll
                for (int m = 0; m < 4; ++m)
#pragma unroll
                    for (int n = 0; n < 2; ++n) acc[a][b][m][n] = (f32x4){0.f, 0.f, 0.f, 0.f};
        cur = nxt; cA = nA; cB = nB; ++ui;
        if (wr == 1) PG8_BAR;
    }
    PG8_WAIT_V(0);
    PG8_BAR;
#undef PG8_SA
#undef PG8_SB
#undef PG8_STAGE
#undef PG8_LDA
#undef PG8_LDB
#undef PG8_MMA
#undef PG8_WAIT_V
#undef PG8_WAIT_L
#undef PG8_BAR
#undef PG8_SCHED
}

struct EpiStore16 {
    static constexpr bool PERM = true;
    bf16_t* O; int ldc;
    __device__ __forceinline__ void operator()(const f32x4 (&acc)[2][2][4][2], const Unit& u, int wr, int wc, int fr, int fq) const {
#pragma unroll
        for (int ai = 0; ai < 2; ++ai)
#pragma unroll
            for (int m = 0; m < 4; ++m) {
                bf16_t* rowp = O + (size_t)(u.pm * BM + ai * HALF + wr * 64 + m * 16 + fr) * ldc + u.pn * BM + wc * 32 + 8 * fq;
#pragma unroll
                for (int bj = 0; bj < 2; ++bj) { const f32x4 v0 = acc[ai][bj][m][0], v1 = acc[ai][bj][m][1];
                    u32x4 w; w.x = pk2(v0[0], v0[1]); w.y = pk2(v0[2], v0[3]); w.z = pk2(v1[0], v1[1]); w.w = pk2(v1[2], v1[3]);
                    *(u32x4*)(rowp + bj * HALF) = w; }
            }
    }
};
struct EpiStore {
    static constexpr bool PERM = true;
    bf16_t* O; int ldc; int ncols; int rope_mode; const float* cosT; const float* sinT;
    __device__ __forceinline__ void operator()(const f32x4 (&acc)[2][2][4][2], const Unit& u, int wr, int wc, int fr, int fq) const {
#pragma unroll
        for (int bj = 0; bj < 2; ++bj) {
            const int cg0 = u.pn * BM + bj * HALF + wc * 32;
            if (cg0 >= ncols) continue;
            const bool rope = (rope_mode == 1) ? (cg0 == ZC_KR) : (rope_mode == 2 ? (((cg0 >> 5) % 3) == 2) : false);
#pragma unroll
            for (int ai = 0; ai < 2; ++ai)
#pragma unroll
                for (int m = 0; m < 4; ++m) {
                    const int row = u.pm * BM + ai * HALF + wr * 64 + m * 16 + fr;
                    f32x4 v0 = acc[ai][bj][m][0], v1 = acc[ai][bj][m][1];
                    if (rope) {
                        const int s = row & (SEQ - 1), ib = 8 * (fq & 1);
                        const f32x4 c0 = *(const f32x4*)(cosT + s * 16 + ib), c1 = *(const f32x4*)(cosT + s * 16 + ib + 4);
                        const f32x4 s0 = *(const f32x4*)(sinT + s * 16 + ib), s1 = *(const f32x4*)(sinT + s * 16 + ib + 4);
                        f32x4 p0, p1;
#pragma unroll
                        for (int e = 0; e < 4; ++e) { p0[e] = __shfl_xor(v0[e], 32); p1[e] = __shfl_xor(v1[e], 32); }
                        if (fq < 2) { v0 = v0 * c0 - p0 * s0; v1 = v1 * c1 - p1 * s1; }
                        else        { v0 = p0 * s0 + v0 * c0; v1 = p1 * s1 + v1 * c1; }
                    }
                    u32x4 w; w.x = pk2(v0[0], v0[1]); w.y = pk2(v0[2], v0[3]); w.z = pk2(v1[0], v1[1]); w.w = pk2(v1[2], v1[3]);
                    *(u32x4*)(O + (size_t)row * ldc + cg0 + 8 * fq) = w;
                }
        }
    }
};

struct EpiGate {
    static constexpr bool PERM = true;
    bf16_t* H; const bf16_t* G; const float* cw; const float* cb;
    __device__ __forceinline__ void operator()(const f32x4 (&acc)[2][2][4][2], const Unit& u, int wr, int wc, int fr, int fq) const {
#pragma unroll
        for (int bj = 0; bj < 2; ++bj) {
            const int col = u.pn * BM + bj * HALF + wc * 32 + 8 * fq;
            f32x4 w0[2], w1[2], w2[2], bb[2];
#pragma unroll
            for (int n = 0; n < 2; ++n) { w0[n] = *(const f32x4*)(cw + col + 4 * n); w1[n] = *(const f32x4*)(cw + DFF + col + 4 * n); w2[n] = *(const f32x4*)(cw + 2 * DFF + col + 4 * n); bb[n] = *(const f32x4*)(cb + col + 4 * n); }
#pragma unroll
            for (int ai = 0; ai < 2; ++ai)
#pragma unroll
                for (int m = 0; m < 4; ++m) {
                    const int row = u.pm * BM + ai * HALF + wr * 64 + m * 16 + fr;
                    const int t = row & (SEQ - 1);
                    const bf16_t* gp = G + (size_t)row * DFF + col;
                    const bool hasm = t > 0, hasn = t < SEQ - 1;
                    u32x4 gm = *(const u32x4*)(gp - (hasm ? DFF : 0));
                    const u32x4 g0 = *(const u32x4*)gp;
                    u32x4 gn = *(const u32x4*)(gp + (hasn ? DFF : 0));
                    const unsigned mm = hasm ? 0xffffffffu : 0u, mn = hasn ? 0xffffffffu : 0u;
                    gm.x &= mm; gm.y &= mm; gm.z &= mm; gm.w &= mm; gn.x &= mn; gn.y &= mn; gn.z &= mn; gn.w &= mn;
                    unsigned ow[4];
#pragma unroll
                    for (int n = 0; n < 2; ++n) {
                        const unsigned m0 = n ? gm.z : gm.x, m1 = n ? gm.w : gm.y, c0 = n ? g0.z : g0.x, c1 = n ? g0.w : g0.y, n0 = n ? gn.z : gn.x, n1 = n ? gn.w : gn.y;
                        const f32x4 fm = {bflo(m0), bfhi(m0), bflo(m1), bfhi(m1)}, f0 = {bflo(c0), bfhi(c0), bflo(c1), bfhi(c1)}, fn = {bflo(n0), bfhi(n0), bflo(n1), bfhi(n1)};
                        const f32x4 gc = bb[n] + fm * w0[n] + f0 * w1[n] + fn * w2[n];
                        const f32x4 a = acc[ai][bj][m][n];
                        float o[4];
#pragma unroll
                        for (int e = 0; e < 4; ++e) {
                            constexpr float C1 = -2.0f * LOG2E * 0.7978845608028654f, C2 = C1 * 0.044715f;
                            const float x = gc[e];
                            const float ex = __builtin_amdgcn_exp2f(x * __builtin_fmaf(x * x, C2, C1));
                            o[e] = (x * a[e]) * __builtin_amdgcn_rcpf(1.0f + ex);
                        }
                        ow[2 * n] = pk2(o[0], o[1]); ow[2 * n + 1] = pk2(o[2], o[3]);
                    }
                    *(u32x4*)(H + (size_t)row * DFF + col) = (u32x4){ow[0], ow[1], ow[2], ow[3]};
                }
        }
    }
};
}

__device__ __forceinline__ s16x4 vtr(LAS const unsigned char* p) { typedef short v4i16_t __attribute__((ext_vector_type(4))); return __builtin_bit_cast(s16x4, __builtin_amdgcn_ds_read_tr16_b64_v4i16((LAS v4i16_t*)p)); }

template <int NK, int NT, int KSTR, class BM>
__device__ __forceinline__ void attn_step(LAS const unsigned char* Kl, LAS const unsigned char* Vl, int kb, const bf16x8 (&q)[NT][NK], f32x4 (&o)[NT][4], float (&mrun)[NT], float (&lrun)[NT], int lane, const BM& bm) {
    constexpr float THR = 8.0f;
    const int i = lane & 15, g = lane >> 4;
    f32x4 s0[NT], s1[NT];
#pragma unroll
    for (int t = 0; t < NT; ++t) { const float nm = -mrun[t]; s0[t] = (f32x4){nm, nm, nm, nm}; s1[t] = s0[t]; }
    LAS const unsigned char* kp = Kl + (kb + i) * KSTR + g * 16;
#pragma unroll
    for (int ks = 0; ks < NK; ++ks) {
        const bf16x8 a0 = *(LAS const bf16x8*)(kp + ks * 64);
        const bf16x8 a1 = *(LAS const bf16x8*)(kp + 16 * KSTR + ks * 64);
#pragma unroll
        for (int t = 0; t < NT; ++t) {
            s0[t] = __builtin_amdgcn_mfma_f32_16x16x32_bf16(a0, q[t][ks], s0[t], 0, 0, 0);
            s1[t] = __builtin_amdgcn_mfma_f32_16x16x32_bf16(a1, q[t][ks], s1[t], 0, 0, 0);
        }
    }
    bf16x8 pb[NT];
#pragma unroll
    for (int t = 0; t < NT; ++t) {
        bm(s0[t], s1[t], kb, t);
        float mx = fmaxf(fmaxf(fmaxf(s0[t][0], s0[t][1]), fmaxf(s0[t][2], s0[t][3])), fmaxf(fmaxf(s1[t][0], s1[t][1]), fmaxf(s1[t][2], s1[t][3])));
        if (__any(mx > THR)) {
            mx = fmaxf(mx, __shfl_xor(mx, 16)); mx = fmaxf(mx, __shfl_xor(mx, 32));
            const float dl = fmaxf(mx, 0.f);
            const float alpha = __builtin_amdgcn_exp2f(-dl);
            mrun[t] += dl; lrun[t] *= alpha;
#pragma unroll
            for (int db = 0; db < 4; ++db) o[t][db] = o[t][db] * alpha;
            s0[t] = s0[t] - dl; s1[t] = s1[t] - dl;
        }
        float p0[4], p1[4]; float ps = 0.f;
#pragma unroll
        for (int j = 0; j < 4; ++j) { p0[j] = __builtin_amdgcn_exp2f(s0[t][j]); p1[j] = __builtin_amdgcn_exp2f(s1[t][j]); ps += p0[j] + p1[j]; }
        lrun[t] += ps;
        u32x4 w; w.x = pk2(p0[0], p0[1]); w.y = pk2(p0[2], p0[3]); w.z = pk2(p1[0], p1[1]); w.w = pk2(p1[2], p1[3]);
        pb[t] = __builtin_bit_cast(bf16x8, w);
    }
    LAS const unsigned char* vp = Vl + (kb + 4 * g + (i >> 2)) * S64 + (i & 3) * 8;
#pragma unroll
    for (int db = 0; db < 4; ++db) {
        const s16x4 lo = vtr(vp + db * 32), hi = vtr(vp + 16 * S64 + db * 32);
        const bf16x8 va = {lo[0], lo[1], lo[2], lo[3], hi[0], hi[1], hi[2], hi[3]};
#pragma unroll
        for (int t = 0; t < NT; ++t) o[t][db] = __builtin_amdgcn_mfma_f32_16x16x32_bf16(va, pb[t], o[t][db], 0, 0, 0);
    }
}

__device__ __forceinline__ bf16x8 load_q(const bf16_t* p, float s) { const u32x4 v = *(const u32x4*)p; return __builtin_bit_cast(bf16x8, scale_bf8(v, s)); }

struct Params { const float* in[20]; float* out; unsigned char* ws; };
enum { I_X = 0, I_C, I_WADA, I_BADA, I_GPREMIX, I_GPOSTMIX, I_GPREFFN, I_GPOSTFFN, I_WIN, I_RPB, I_T5, I_GQ, I_GKV, I_WUQ, I_WUKV, I_WOUT, I_WUP, I_CONVW, I_CONVB, I_WDOWN };

__device__ const unsigned char T5B[3][65] = {
 {0,1,2,3,4,5,6,7,8,8,8,8,8,8,8,9,9,9,9,9,9,9,9,9,9,9,9,10,10,10,10,10,10,10,10,10,10,10,10,10,10,10,10,10,10,10,10,10,10,10,11,11,11,11,11,11,11,11,11,11,11,11,11,11,11},
 {0,4,8,8,9,9,9,10,10,10,10,10,10,11,11,11,11,11,11,11,11,11,11,12,12,12,12,12,12,12,12,12,12,12,12,12,12,12,12,12,12,12,13,13,13,13,13,13,13,13,13,13,13,13,13,13,13,13,13,13,13,13,13,13,13},
 {0,9,10,10,11,11,12,12,12,12,12,13,13,13,13,13,13,13,13,13,14,14,14,14,14,14,14,14,14,14,14,14,14,14,14,15,15,15,15,15,15,15,15,15,15,15,15,15,15,15,15,15,15,15,15,15,15,15,15,15,15,15,15,15,15}};

__device__ __forceinline__ void transpose_item(const float* W, int K, int N, bf16_t* WT, const float* ksc, LAS float* scr, int item, int lane) {
    const int nblk = N / 32, kb = item / nblk, nb = item % nblk, k0 = 64 * kb, n0 = 32 * nb;
#pragma unroll 8
    for (int i = 0; i < 32; ++i) { const int kk = 2 * i + (lane >> 5); float v = W[(size_t)(k0 + kk) * N + n0 + (lane & 31)]; if (ksc) v *= ksc[k0 + kk]; scr[kk * 33 + (lane & 31)] = v; }
    asm volatile("s_waitcnt lgkmcnt(0)" ::: "memory");
    const int c = lane & 7;
#pragma unroll
    for (int j = 0; j < 4; ++j) { const int n = (lane >> 3) + 8 * j; const LAS float* s = scr + (8 * c) * 33 + n;
        u32x4 o; o.x = pk2(s[0 * 33], s[1 * 33]); o.y = pk2(s[2 * 33], s[3 * 33]); o.z = pk2(s[4 * 33], s[5 * 33]); o.w = pk2(s[6 * 33], s[7 * 33]);
        *(u32x4*)(WT + (size_t)(n0 + n) * K + k0 + 8 * c) = o; }
    asm volatile("s_waitcnt lgkmcnt(0)" ::: "memory");
}

template <int R>
__device__ __forceinline__ void rowwise_rows(int row0, int rstride, const float* xin, const bf16_t* y, const float* gpost, int gate_off, const float* modb, float* xout,
                                             const float* gpre, int sc_off, int sh_off, bf16_t* XN, int lane) {
    f32x4 v[R][4]; u32x2 yw[R][4];
#pragma unroll
    for (int r = 0; r < R; ++r) { const size_t ro = (size_t)(row0 + r * rstride) * DM + 4 * lane;
#pragma unroll
        for (int j = 0; j < 4; ++j) v[r][j] = *(const f32x4*)(xin + ro + 256 * j);
        if (y) {
#pragma unroll
            for (int j = 0; j < 4; ++j) yw[r][j] = *(const u32x2*)(y + ro + 256 * j); } }
#pragma unroll
    for (int r = 0; r < R; ++r) {
        const int row = row0 + r * rstride; const size_t ro = (size_t)row * DM + 4 * lane;
        const float* md = modb + (size_t)(row >> 12) * 6144;
        if (y) {
            f32x4 yv[4]; float ss = 0.f;
#pragma unroll
            for (int j = 0; j < 4; ++j) { const u32x2 w = yw[r][j]; yv[j] = (f32x4){bflo(w.x), bfhi(w.x), bflo(w.y), bfhi(w.y)};
                ss += (yv[j][0] * yv[j][0] + yv[j][1] * yv[j][1]) + (yv[j][2] * yv[j][2] + yv[j][3] * yv[j][3]); }
            const float rr = rsqrtf(wave_sum(ss) * (1.0f / DM) + EPS);
#pragma unroll
            for (int j = 0; j < 4; ++j) { const f32x4 gp = *(const f32x4*)(gpost + 4 * lane + 256 * j), gt = *(const f32x4*)(md + gate_off + 4 * lane + 256 * j);
                v[r][j] = v[r][j] + gt * (yv[j] * rr * gp); }
        }
        if (xout) {
#pragma unroll
            for (int j = 0; j < 4; ++j) *(f32x4*)(xout + ro + 256 * j) = v[r][j];
        }
        if (XN) {
            float ss = 0.f;
#pragma unroll
            for (int j = 0; j < 4; ++j) ss += (v[r][j][0] * v[r][j][0] + v[r][j][1] * v[r][j][1]) + (v[r][j][2] * v[r][j][2] + v[r][j][3] * v[r][j][3]);
            const float rr = rsqrtf(wave_sum(ss) * (1.0f / DM) + EPS);
#pragma unroll
            for (int j = 0; j < 4; ++j) { const f32x4 gp = *(const f32x4*)(gpre + 4 * lane + 256 * j), s1 = *(const f32x4*)(md + sc_off + 4 * lane + 256 * j), s0 = *(const f32x4*)(md + sh_off + 4 * lane + 256 * j);
                const f32x4 h = (v[r][j] * rr * gp) * (s1 + 1.0f) + s0;
                u32x2 w; w.x = pk2(h[0], h[1]); w.y = pk2(h[2], h[3]); *(u32x2*)(XN + ro + 256 * j) = w; }
        }
    }
}

#define XB_TMO      128
#define XB_XCNT(j)  (256  + 64 * (j))
#define XB_XSUB(j)  (1280 + 64 * (j))
#define XB_XGEN(j)  (2304 + 64 * (j))
#define XB_TOP      3328
#define XB_TOPGEN   3392
#define XCD_BAR_WORDS 3456
#define XB_SPIN_CAP (1u << 20)
__device__ __forceinline__ unsigned xb_ld(unsigned* p)              { return __hip_atomic_load(p, __ATOMIC_RELAXED, __HIP_MEMORY_SCOPE_AGENT); }
__device__ __forceinline__ unsigned xb_add(unsigned* p, unsigned v) { return __hip_atomic_fetch_add(p, v, __ATOMIC_RELAXED, __HIP_MEMORY_SCOPE_AGENT); }
__device__ __forceinline__ unsigned xb_xcc_id() { return (unsigned)__builtin_amdgcn_s_getreg((3 << 11) | 20) & 0xFu; }
#define XB_SPIN(cond, bar) do { unsigned _sp = 0; while (cond) { __builtin_amdgcn_s_sleep(1); \
    if ((++_sp & 255u) == 0u) { if (xb_ld(&(bar)[XB_TMO])) break; if (_sp > XB_SPIN_CAP) { atomicAdd(&(bar)[XB_TMO], 1u); break; } } } } while (0)
struct XcdBarrier { unsigned* bar; unsigned x; volatile LAS unsigned* st; };
__device__ __forceinline__ XcdBarrier xcd_barrier_post(unsigned* bar, volatile LAS unsigned* st) {
    XcdBarrier b; b.bar = bar; b.x = xb_xcc_id(); b.st = st;
    if (threadIdx.x == 0) (void)xb_add(&bar[XB_XCNT(b.x)], 1u);
    return b;
}
__device__ __forceinline__ void xcd_barrier_complete(unsigned* bar, unsigned x, unsigned& nloc, unsigned& nx) {
    const unsigned G = gridDim.x * gridDim.y * gridDim.z;
    unsigned sum, cnt, mine, sp = 0u;
    for (;;) {
        sum = 0u; cnt = 0u; mine = 0u;
#pragma unroll
        for (unsigned j = 0; j < 16; ++j) { const unsigned c = xb_ld(&bar[XB_XCNT(j)]); sum += c; cnt += (c > 0u) ? 1u : 0u; mine = (j == x) ? c : mine; }
        if (sum == G) break;
        __builtin_amdgcn_s_sleep(1);
        if ((++sp & 255u) == 0u) { if (xb_ld(&bar[XB_TMO])) break; if (sp > XB_SPIN_CAP) { atomicAdd(&bar[XB_TMO], 1u); break; } }
    }
    nloc = mine > 0u ? mine : 1u; nx = cnt > 0u ? cnt : 1u;
}
__device__ __forceinline__ void xcd_barrier(const XcdBarrier& b) {
    asm volatile("s_waitcnt vmcnt(0)" ::: "memory");
    __syncthreads();
    if (threadIdx.x == 0) {
        unsigned* bar = b.bar; unsigned bx = b.x;
        asm volatile("" : "+s"(bx));
        __builtin_amdgcn_s_waitcnt(0);
        unsigned nloc = b.st[0], nx = b.st[1];
        if (nloc == 0u) { xcd_barrier_complete(bar, bx, nloc, nx); b.st[0] = nloc; b.st[1] = nx; }
        const unsigned old = xb_add(&bar[XB_XSUB(bx)], 1u);
        const unsigned gen = old / nloc;
        if (old + 1u == (gen + 1u) * nloc) {
            __builtin_amdgcn_fence(__ATOMIC_RELEASE, "agent");
            asm volatile("s_waitcnt vmcnt(0)" ::: "memory");
            const unsigned og = xb_add(&bar[XB_TOP], 1u);
            const unsigned tg = og / nx;
            if (og + 1u == (tg + 1u) * nx) xb_add(&bar[XB_TOPGEN], 1u);
            else XB_SPIN(xb_ld(&bar[XB_TOPGEN]) == tg, bar);
            __builtin_amdgcn_fence(__ATOMIC_ACQUIRE, "agent");
            xb_add(&bar[XB_XGEN(bx)], 1u);
            asm volatile("s_waitcnt vmcnt(0)" ::: "memory");
        } else {
            XB_SPIN(xb_ld(&bar[XB_XGEN(bx)]) == gen, bar);
            __builtin_amdgcn_fence(__ATOMIC_ACQUIRE, "agent");
            asm volatile("s_waitcnt vmcnt(0)" ::: "memory");
        }
    }
    __syncthreads();
}

constexpr int LDS_BYTES = 148 * 1024;

__global__ void __launch_bounds__(NTHR, 2) fwd_megakernel(Params P) {
    extern __shared__ __attribute__((aligned(16))) unsigned char lds_raw[];
    LAS unsigned char* lds = (LAS unsigned char*)lds_raw;
    cg::grid_group grid = cg::this_grid();
    volatile LAS unsigned* MISC = (volatile LAS unsigned*)(lds + 3 * 128 * (S96 + S64) + 64);
    if (threadIdx.x < 32) MISC[threadIdx.x] = 0u;
    unsigned* barw = (unsigned*)(P.ws + WS_BAR);
    if (blockIdx.x == 0) for (int i = threadIdx.x; i < XCD_BAR_WORDS; i += NTHR) __hip_atomic_store(barw + i, 0u, __ATOMIC_RELAXED, __HIP_MEMORY_SCOPE_AGENT);
    asm volatile("s_waitcnt vmcnt(0)" ::: "memory");
    __syncthreads();
    grid.sync();
    __builtin_amdgcn_fence(__ATOMIC_ACQUIRE, "agent");
    asm volatile("s_waitcnt vmcnt(0)" ::: "memory");
    const XcdBarrier xbar = xcd_barrier_post(barw, MISC + 8);
#define GSYNC() xcd_barrier(xbar)
    const int G = gridDim.x, bid = blockIdx.x, NGW = G * NWAVE;
#define LOCAL_IDS int tid = threadIdx.x; asm volatile("" : "+v"(tid)); const int lane = tid & 63, wave = __builtin_amdgcn_readfirstlane(tid >> 6), gw = bid * NWAVE + wave; (void)lane; (void)gw;
    unsigned char* ws = P.ws;
    float* modp = (float*)(ws + WS_MOD);
    float* cosT = (float*)(ws + WS_ROPE); float* sinT = cosT + SEQ * 16;
    float* rq = (float*)(ws + WS_RQ); float* rkv = rq + MTOK;
    float* lutg = (float*)(ws + WS_LUT);
    float* lse = (float*)(ws + WS_LSE);
    bf16_t* XN = (bf16_t*)(ws + WS_XN);
    bf16_t* Z = (bf16_t*)(ws + WS_Z);
    bf16_t* QB = (bf16_t*)(ws + WS_Q);
    bf16_t* KVB = (bf16_t*)(ws + WS_KV);
    bf16_t* PART = (bf16_t*)(ws + WS_PART);
    bf16_t* OB = XN;
    bf16_t* YMIX = Z;
    bf16_t* GB = (bf16_t*)(ws + WS_G);
    bf16_t* HID = (bf16_t*)(ws + WS_HID);
    bf16_t* YFFN = XN;

    {
        LOCAL_IDS
        LAS float* scr = (LAS float*)(lds + wave * 16384);
        constexpr int IT_IN = 16 * 93, IT_OUT = 16 * 32, IT_UP = 16 * 176, IT_DOWN = 44 * 32, IT_UQ = 6 * 12, IT_UKV = 4 * 16;
        constexpr int IT_L = IT_IN + IT_OUT + IT_UP + IT_DOWN + IT_UQ + IT_UKV;
        for (int it = gw; it < DEPTH * IT_L; it += NGW) {
            const int l = it / IT_L; int r = it % IT_L;
            unsigned char* wl = ws + WS_W + (size_t)l * WL_STRIDE;
            if (r < IT_IN) { transpose_item(P.in[I_WIN] + (size_t)l * DM * DIN, DM, DIN, (bf16_t*)(wl + WL_IN), nullptr, scr, r, lane); continue; } r -= IT_IN;
            if (r < IT_OUT) { transpose_item(P.in[I_WOUT] + (size_t)l * DM * DM, DM, DM, (bf16_t*)(wl + WL_OUT), nullptr, scr, r, lane); continue; } r -= IT_OUT;
            if (r < IT_UP) { transpose_item(P.in[I_WUP] + (size_t)l * DM * 2 * DFF, DM, 2 * DFF, (bf16_t*)(wl + WL_UP), nullptr, scr, r, lane); continue; } r -= IT_UP;
            if (r < IT_DOWN) { transpose_item(P.in[I_WDOWN] + (size_t)l * DFF * DM, DFF, DM, (bf16_t*)(wl + WL_DOWN), nullptr, scr, r, lane); continue; } r -= IT_DOWN;
            if (r < IT_UQ) { transpose_item(P.in[I_WUQ] + (size_t)l * 384 * 384, 384, 384, (bf16_t*)(wl + WL_UQ), P.in[I_GQ] + l * 384, scr, r, lane); continue; } r -= IT_UQ;
            transpose_item(P.in[I_WUKV] + (size_t)l * 256 * 512, 256, 512, (bf16_t*)(wl + WL_UKV), P.in[I_GKV] + l * 256, scr, r, lane);
        }
        {
            constexpr int PZ_IN = 96 * 1024 / 8, PZ_UQ = 128 * 384 / 8, PZ_L = PZ_IN + PZ_UQ;
            const u32x4 z4 = {0u, 0u, 0u, 0u};
            for (int it = bid * NTHR + tid; it < DEPTH * PZ_L; it += G * NTHR) {
                const int l = it / PZ_L, r = it % PZ_L;
                unsigned char* wl = ws + WS_W + (size_t)l * WL_STRIDE;
                if (r < PZ_IN) *(u32x4*)(wl + WL_IN + (size_t)DIN * DM * 2 + (size_t)r * 16) = z4;
                else *(u32x4*)(wl + WL_UQ + (size_t)384 * 384 * 2 + (size_t)(r - PZ_IN) * 16) = z4;
            }
        }
        for (int it = bid * NTHR + tid; it < SEQ * 16; it += G * NTHR) {
            const int s = it >> 4, i = it & 15;
            const float invf = powf(10000.0f, -(float)(2 * i) / 32.0f);
            const float ang = (float)s * invf;
            const double t = (double)ang * 0.15915494309189535;
            const float fr = (float)(t - floor(t));
            cosT[it] = __builtin_amdgcn_cosf(fr); sinT[it] = __builtin_amdgcn_sinf(fr);
        }
        for (int it = bid * NTHR + tid; it < 3 * 8 * 129; it += G * NTHR) {
            const int p = it / (8 * 129), h = (it / 129) % 8, idx = it % 129, rel = idx - 64, n = rel < 0 ? -rel : rel;
            const int bk = (int)T5B[p][n] + (rel > 0 ? 16 : 0);
            lutg[(p * 8 + h) * 132 + idx] = P.in[I_T5][bk * 8 + h] * LOG2E;
        }
        __syncthreads();
        for (int pair = bid; pair < 96; pair += G) {
            const int l = pair / 24, nc = pair % 24, ks = wave;
#pragma unroll 4
            for (int e = lane; e < 2048; e += 64) { const int b = e >> 7, k = e & 127; const float cv = P.in[I_C][b * DM + ks * 128 + k]; scr[e] = cv / (1.0f + __expf(-cv)); }
            asm volatile("s_waitcnt lgkmcnt(0)" ::: "memory");
            f32x4 accm[16];
#pragma unroll
            for (int b = 0; b < 16; ++b) accm[b] = (f32x4){0.f, 0.f, 0.f, 0.f};
            const float* wp = P.in[I_WADA] + ((size_t)l * DM + ks * 128) * 6144 + nc * 256 + 4 * lane;
#pragma unroll 4
            for (int k = 0; k < 128; ++k) {
                const f32x4 w = *(const f32x4*)(wp + (size_t)k * 6144);
#pragma unroll
                for (int b = 0; b < 16; ++b) accm[b] = accm[b] + w * scr[b * 128 + k];
            }
            asm volatile("s_waitcnt lgkmcnt(0)" ::: "memory");
#pragma unroll
            for (int b = 0; b < 16; ++b) *(LAS f32x4*)(scr + b * 256 + 4 * lane) = accm[b];
            __syncthreads();
            const LAS float* part = (const LAS float*)lds;
#pragma unroll
            for (int j = 0; j < 8; ++j) {
                const int o = tid + NTHR * j, b = o >> 8, n = o & 255;
                float sum = P.in[I_BADA][l * 6144 + nc * 256 + n];
#pragma unroll
                for (int w = 0; w < 8; ++w) sum += part[w * 4096 + o];
                modp[((size_t)l * 16 + b) * 6144 + nc * 256 + n] = sum;
            }
            __syncthreads();
        }
    }
    GSYNC();
    { LOCAL_IDS
    for (int row = gw; row < MTOK; row += 4 * NGW)
        rowwise_rows<4>(row, NGW, P.in[I_X], nullptr, nullptr, 0, modp, nullptr, P.in[I_GPREMIX], 1024, 0, XN, lane);
    }
    GSYNC();

    for (int l = 0; l < DEPTH; ++l) {
        unsigned char* wl = ws + WS_W + (size_t)l * WL_STRIDE;
        const float* modl = modp + (size_t)l * 16 * 6144;
        {
            pg8::Gemm g{XN, (const bf16_t*)(wl + WL_IN), MTOK, ZLD, DM, DM}; pg8::StaticOrder S; S.init(MTOK, ZLD, G, bid);
            pg8::EpiStore E{Z, ZLD, ZLD, 1, cosT, sinT};
            pg8::gemm_phase(lds, g, S, E);
        }
        GSYNC();
        {
            pg8::Gemm g{Z + ZC_CQ, (const bf16_t*)(wl + WL_UQ), MTOK, 512, 384, ZLD}; pg8::StaticOrder S; S.init(MTOK, 512, G, bid);
            pg8::EpiStore E{QB, 384, 384, 2, cosT, sinT};
            pg8::gemm_phase(lds, g, S, E);
        }
        {
            pg8::Gemm g{Z + ZC_CKV, (const bf16_t*)(wl + WL_UKV), MTOK, 512, 256, ZLD}; pg8::StaticOrder S; S.init(MTOK, 512, G, bid);
            pg8::EpiStore16 E{KVB, 512};
            pg8::gemm_phase(lds, g, S, E);
        }
        { LOCAL_IDS
        for (int row0 = gw; row0 < MTOK; row0 += 4 * NGW) {
            u32x4 v0[4], v1[4];
#pragma unroll
            for (int r = 0; r < 4; ++r) { const bf16_t* zr = Z + (size_t)(row0 + r * NGW) * ZLD + ZC_CQ; v0[r] = *(const u32x4*)(zr + 8 * lane);
                v1[r] = (u32x4){0u, 0u, 0u, 0u}; if (lane < 16) v1[r] = *(const u32x4*)(zr + 8 * (lane + 64)); }
#pragma unroll
            for (int r = 0; r < 4; ++r) {
                const u32x4 a = v0[r], c = v1[r];
                const float s0 = bflo(a.x) * bflo(a.x) + bfhi(a.x) * bfhi(a.x) + bflo(a.y) * bflo(a.y) + bfhi(a.y) * bfhi(a.y) + bflo(a.z) * bflo(a.z) + bfhi(a.z) * bfhi(a.z) + bflo(a.w) * bflo(a.w) + bfhi(a.w) * bfhi(a.w);
                const float s1 = bflo(c.x) * bflo(c.x) + bfhi(c.x) * bfhi(c.x) + bflo(c.y) * bflo(c.y) + bfhi(c.y) * bfhi(c.y) + bflo(c.z) * bflo(c.z) + bfhi(c.z) * bfhi(c.z) + bflo(c.w) * bflo(c.w) + bfhi(c.w) * bfhi(c.w);
                float sq = lane < 48 ? s0 : 0.f, sk = (lane < 48 ? 0.f : s0) + s1;
                sq = wave_sum(sq); sk = wave_sum(sk);
                if (lane == 0) { const int row = row0 + r * NGW; rq[row] = rsqrtf(sq * (1.0f / 384.0f) + EPS); rkv[row] = rsqrtf(sk * (1.0f / 256.0f) + EPS); }
            }
        } }
        {
            LOCAL_IDS
            LAS unsigned char* Kl = lds; LAS unsigned char* Vl = lds + 400 * S64; LAS float* biasL = (LAS float*)(lds + 2 * 400 * S64);
            const int i = lane & 15, g4 = lane >> 4, w16 = 16 * wave;
            const int per = (24 * 256 + G - 1) / G, u0 = bid * per, u1 = min(u0 + per, 24 * 256);
            u32x4 pk[6], pvv[6], pq[2][2];
            if (tid < S64) { const u32x4 z4 = {0u, 0u, 0u, 0u}; *(LAS u32x4*)(Kl + 384 * S64 + tid * 16) = z4; *(LAS u32x4*)(Vl + 384 * S64 + tid * 16) = z4; }
            auto decode = [&](int unit, int& p, int& h, int& b, int& r, int& mb, int& dl) {
                const int ph = unit >> 8, rest = unit & 255; p = ph >> 3; h = ph & 7; b = rest >> 4; const int rm = rest & 15;
                dl = 2 * p; const int nmb = 16 >> dl; r = rm / nmb; mb = rm % nmb; };
            auto issue = [&](int unit) {
                int p, h, b, r, mb, dl; decode(unit, p, h, b, r, mb, dl);
                const int L = SEQ >> dl;
                const bf16_t* zb = Z + (size_t)b * SEQ * ZLD + 64 * h;
#pragma unroll
                for (int it = 0; it < 6; ++it) {
                    const int c = tid + NTHR * it, row = c >> 3, ch = c & 7, mk = 256 * mb - 64 + row;
                    pk[it] = (u32x4){0u, 0u, 0u, 0u}; pvv[it] = (u32x4){0u, 0u, 0u, 0u};
                    if (mk >= 0 && mk < L) { const bf16_t* src = zb + (size_t)((mk << dl) + r) * ZLD + 8 * ch; pk[it] = *(const u32x4*)(src + ZC_KB); pvv[it] = *(const u32x4*)(src + ZC_VB); }
                }
#pragma unroll
                for (int t = 0; t < 2; ++t) { const int tq = ((256 * mb + 128 * t + w16 + i) << dl) + r;
                    const bf16_t* qp = zb + (size_t)tq * ZLD + ZC_QB + 8 * g4; pq[t][0] = *(const u32x4*)qp; pq[t][1] = *(const u32x4*)(qp + 32); }
            };
            auto commit = [&]() {
#pragma unroll
                for (int it = 0; it < 6; ++it) { const int c = tid + NTHR * it, row = c >> 3, ch = c & 7;
                    *(LAS u32x4*)(Kl + row * S64 + ch * 16) = pk[it]; *(LAS u32x4*)(Vl + row * S64 + ch * 16) = pvv[it]; }
            };
            int cur_ph = -1;
            issue(min(u0, 24 * 256 - 1));
            for (int unit = u0; unit < u1; ++unit) {
                int p, h, b, r, mb, dl; decode(unit, p, h, b, r, mb, dl);
                const int L = SEQ >> dl, nmb = 16 >> dl;
                commit();
                if ((unit >> 8) != cur_ph) {
                    cur_ph = unit >> 8;
                    const float* lg = lutg + cur_ph * 132;
                    for (int e = tid; e < 2560; e += NTHR) { const int st = e >> 9, ln = (e >> 3) & 63, jj = e & 7;
                        const int rel = 32 * st + 4 * (ln >> 4) + (jj & 3) + 16 * (jj >> 2) - 64 - (ln & 15); const bool ok = (rel >= -64) && (rel <= 64);
                        biasL[e] = ok ? lg[min(max(rel + 64, 0), 128)] : -INFINITY; }
                }
                bf16x8 qf[2][1][2]; f32x4 o[2][1][4]; float mr[2][1], lr[2][1];
#pragma unroll
                for (int t = 0; t < 2; ++t) {
                    qf[t][0][0] = __builtin_bit_cast(bf16x8, scale_bf8(pq[t][0], 0.125f * LOG2E)); qf[t][0][1] = __builtin_bit_cast(bf16x8, scale_bf8(pq[t][1], 0.125f * LOG2E));
                    mr[t][0] = 0.f; lr[t][0] = 0.f;
#pragma unroll
                    for (int db = 0; db < 4; ++db) o[t][0][db] = (f32x4){0.f, 0.f, 0.f, 0.f};
                }
                __syncthreads();
                if (unit + 1 < u1) issue(unit + 1);
                const bool edge = (mb == 0) || (mb == nmb - 1);
#pragma unroll 1
                for (int st = 0; st < 5; ++st) {
                    auto bm = [&](f32x4& s0, f32x4& s1, int kb, int) {
                        const LAS f32x4* bp = (const LAS f32x4*)(biasL + (st * 64 + lane) * 8);
                        s0 = s0 + bp[0]; s1 = s1 + bp[1];
                        if (edge) {
#pragma unroll
                            for (int j = 0; j < 4; ++j) { const int mk0 = 256 * mb - 64 + kb + 4 * g4 + j, mk1 = mk0 + 16;
                                if (mk0 < 0 || mk0 >= L) s0[j] = -INFINITY; if (mk1 < 0 || mk1 >= L) s1[j] = -INFINITY; }
                        }
                    };
#pragma unroll
                    for (int t = 0; t < 2; ++t) attn_step<2, 1, S64>(Kl, Vl, 128 * t + w16 + 32 * st, qf[t], o[t], mr[t], lr[t], lane, bm);
                }
#pragma unroll
                for (int t = 0; t < 2; ++t) {
                    const int tq = ((256 * mb + 128 * t + w16 + i) << dl) + r;
                    float lt = lr[t][0]; lt += __shfl_xor(lt, 16); lt += __shfl_xor(lt, 32);
                    const float inv = 1.0f / lt;
                    bf16_t* op = PART + ((size_t)p * MTOK + (size_t)b * SEQ + tq) * 512 + 64 * h + 4 * g4;
#pragma unroll
                    for (int db = 0; db < 4; ++db) { u32x2 w; w.x = pk2(o[t][0][db][0] * inv, o[t][0][db][1] * inv); w.y = pk2(o[t][0][db][2] * inv, o[t][0][db][3] * inv); *(u32x2*)(op + 16 * db) = w; }
                    if (g4 == 0) lse[((size_t)p * MTOK + (size_t)b * SEQ + tq) * 8 + h] = mr[t][0] + __log2f(lt);
                }
                __syncthreads();
            }
        }
        GSYNC();
        {
            LOCAL_IDS
            constexpr int KB_BYTES = 128 * S96, BUF_BYTES = 128 * S96 + 128 * S64;
            const int i = lane & 15, g4 = lane >> 4;
            const float qscale = 0.10206207261596575f * LOG2E;
            for (int unit = bid; unit < 1024; unit += G) {
                const int b = unit >> 6, h = (unit >> 4) & 3, qb = unit & 15;
                const size_t tb = (size_t)b * SEQ;
                bf16x8 qf[2][3];
#pragma unroll
                for (int t = 0; t < 2; ++t) { const size_t row = tb + qb * 256 + 32 * wave + 16 * t + i; const float sc = rq[row] * qscale;
                    const bf16_t* qp = QB + row * 384 + 96 * h + 8 * g4;
#pragma unroll
                    for (int ks = 0; ks < 3; ++ks) qf[t][ks] = load_q(qp + 32 * ks, sc); }
                f32x4 o[2][4];
#pragma unroll
                for (int t = 0; t < 2; ++t)
#pragma unroll
                    for (int db = 0; db < 4; ++db) o[t][db] = (f32x4){0.f, 0.f, 0.f, 0.f};
                u32x4 pre[5]; unsigned prs;
                auto issue = [&](int c) {
                    int t2 = tid; asm volatile("" : "+v"(t2));
                    const unsigned offKV = (unsigned)(t2 >> 3) * 1024u + (unsigned)(t2 & 7) * 16u, offZ = (unsigned)(t2 >> 2) * (unsigned)(ZLD * 2) + (unsigned)(t2 & 3) * 16u;
                    const size_t key0 = tb + (size_t)c * 128;
                    const char* kvb = (const char*)(KVB + key0 * 512 + 128 * h);
                    pre[0] = *(const u32x4*)(kvb + offKV); pre[1] = *(const u32x4*)(kvb + 65536 + offKV);
                    pre[2] = *(const u32x4*)(kvb + 128 + offKV); pre[3] = *(const u32x4*)(kvb + 128 + 65536 + offKV);
                    pre[4] = *(const u32x4*)((const char*)(Z + key0 * ZLD + ZC_KR) + offZ);
                    prs = pk2(rkv[key0 + (t2 >> 3)], rkv[key0 + 64 + (t2 >> 3)]);
                };
                auto commit = [&](int buf) {
                    int t2 = tid; asm volatile("" : "+v"(t2));
                    const int ldsK = (t2 >> 3) * S96 + (t2 & 7) * 16, ldsV = KB_BYTES + (t2 >> 3) * S64 + (t2 & 7) * 16, ldsR = (t2 >> 2) * S96 + 128 + (t2 & 3) * 16;
                    LAS unsigned char* base = lds + buf * BUF_BYTES;
                    *(LAS u32x4*)(base + ldsK) = scale_bf8(pre[0], bflo(prs)); *(LAS u32x4*)(base + ldsK + 64 * S96) = scale_bf8(pre[1], bfhi(prs));
                    *(LAS u32x4*)(base + ldsV) = scale_bf8(pre[2], bflo(prs)); *(LAS u32x4*)(base + ldsV + 64 * S64) = scale_bf8(pre[3], bfhi(prs));
                    *(LAS u32x4*)(base + ldsR) = pre[4];
                };
                constexpr float THR = 8.0f;
                bf16x8 kf[6]; f32x4 s0[2], s1[2], negm[2], lacc[2];
                const bf16x8 ones = {0x3f80, 0x3f80, 0x3f80, 0x3f80, 0x3f80, 0x3f80, 0x3f80, 0x3f80};
#pragma unroll
                for (int t = 0; t < 2; ++t) { negm[t] = (f32x4){0.f, 0.f, 0.f, 0.f}; lacc[t] = (f32x4){0.f, 0.f, 0.f, 0.f}; }
                auto kload = [&](LAS const unsigned char* Kl, int kb) {
                    LAS const unsigned char* kp = Kl + (kb + i) * S96 + g4 * 16;
#pragma unroll
                    for (int ks = 0; ks < 3; ++ks) { kf[2 * ks] = *(LAS const bf16x8*)(kp + ks * 64); kf[2 * ks + 1] = *(LAS const bf16x8*)(kp + 16 * S96 + ks * 64); }
                };
                auto qkm = [&]() {
#pragma unroll
                    for (int t = 0; t < 2; ++t) {
                        s0[t] = __builtin_amdgcn_mfma_f32_16x16x32_bf16(kf[0], qf[t][0], negm[t], 0, 0, 0);
                        s1[t] = __builtin_amdgcn_mfma_f32_16x16x32_bf16(kf[1], qf[t][0], negm[t], 0, 0, 0);
                    }
#pragma unroll
                    for (int ks = 1; ks < 3; ++ks)
#pragma unroll
                        for (int t = 0; t < 2; ++t) {
                            s0[t] = __builtin_amdgcn_mfma_f32_16x16x32_bf16(kf[2 * ks], qf[t][ks], s0[t], 0, 0, 0);
                            s1[t] = __builtin_amdgcn_mfma_f32_16x16x32_bf16(kf[2 * ks + 1], qf[t][ks], s1[t], 0, 0, 0);
                        }
                };
                auto smpv = [&](LAS const unsigned char* vp) {
                    bf16x8 pb[2];
#pragma unroll
                    for (int t = 0; t < 2; ++t) {
                        float mx = __builtin_fmaxf(__builtin_fmaxf(s0[t][0], s0[t][1]), s0[t][2]);
                        mx = __builtin_fmaxf(__builtin_fmaxf(mx, s0[t][3]), s1[t][0]);
                        mx = __builtin_fmaxf(__builtin_fmaxf(mx, s1[t][1]), s1[t][2]);
                        mx = __builtin_fmaxf(mx, s1[t][3]);
                        if (__any(mx > THR)) {
                            mx = fmaxf(mx, __shfl_xor(mx, 16)); mx = fmaxf(mx, __shfl_xor(mx, 32));
                            const float dl = fmaxf(mx, 0.f);
                            const float alpha = __builtin_amdgcn_exp2f(-dl);
                            negm[t] = negm[t] - dl;
                            lacc[t] = lacc[t] * alpha;
#pragma unroll
                            for (int db = 0; db < 4; ++db) o[t][db] = o[t][db] * alpha;
                            s0[t] = s0[t] - dl; s1[t] = s1[t] - dl;
                        }
                        u32x4 w;
                        w.x = pk2(__builtin_amdgcn_exp2f(s0[t][0]), __builtin_amdgcn_exp2f(s0[t][1])); w.y = pk2(__builtin_amdgcn_exp2f(s0[t][2]), __builtin_amdgcn_exp2f(s0[t][3]));
                        w.z = pk2(__builtin_amdgcn_exp2f(s1[t][0]), __builtin_amdgcn_exp2f(s1[t][1])); w.w = pk2(__builtin_amdgcn_exp2f(s1[t][2]), __builtin_amdgcn_exp2f(s1[t][3]));
                        pb[t] = __builtin_bit_cast(bf16x8, w);
                    }
#pragma unroll
                    for (int t = 0; t < 2; ++t) lacc[t] = __builtin_amdgcn_mfma_f32_16x16x32_bf16(ones, pb[t], lacc[t], 0, 0, 0);
#pragma unroll
                    for (int db = 0; db < 4; ++db) {
                        const s16x4 lo = vtr(vp + db * 32), hi = vtr(vp + 16 * S64 + db * 32);
                        const bf16x8 va = {lo[0], lo[1], lo[2], lo[3], hi[0], hi[1], hi[2], hi[3]};
#pragma unroll
                        for (int t = 0; t < 2; ++t) o[t][db] = __builtin_amdgcn_mfma_f32_16x16x32_bf16(va, pb[t], o[t][db], 0, 0, 0);
                    }
                };
#define MLA_VP(VL, KBV) ((VL) + ((KBV) + 4 * g4 + (i >> 2)) * S64 + (i & 3) * 8)
#define MLA_STEP(KLN, KBN, VL, KBV) do { kload(KLN, KBN); __builtin_amdgcn_sched_barrier(0); smpv(MLA_VP(VL, KBV)); qkm(); __builtin_amdgcn_sched_barrier(0); } while (0)
                issue(0); commit(0); issue(1);
                __syncthreads();
                kload(lds, 0); qkm();
                int bc = 0;
                for (int c = 0; c < 32; ++c) {
                    const int bn = (bc == 2) ? 0 : bc + 1;
                    if (c + 1 < 32) commit(bn);
                    if (c + 2 < 32) issue(c + 2);
                    LAS const unsigned char* Kl = lds + bc * BUF_BYTES; LAS const unsigned char* Vl = Kl + KB_BYTES;
                    MLA_STEP(Kl, 32, Vl, 0);
                    MLA_STEP(Kl, 64, Vl, 32);
                    MLA_STEP(Kl, 96, Vl, 64);
                    __syncthreads();
                    if (c + 1 < 32) { MLA_STEP(lds + bn * BUF_BYTES, 0, Vl, 96); }
                    else { smpv(MLA_VP(Vl, 96)); }
                    bc = bn;
                }
#undef MLA_STEP
#undef MLA_VP
                __syncthreads();
#pragma unroll
                for (int t = 0; t < 2; ++t) {
                    const float inv = 1.0f / lacc[t][0];
                    bf16_t* op = OB + (tb + qb * 256 + 32 * wave + 16 * t + i) * DM + 768 + 64 * h + 4 * g4;
#pragma unroll
                    for (int db = 0; db < 4; ++db) { u32x2 w; w.x = pk2(o[t][db][0] * inv, o[t][db][1] * inv); w.y = pk2(o[t][db][2] * inv, o[t][db][3] * inv); *(u32x2*)(op + 16 * db) = w; }
                }
            }
        }
        {
            LOCAL_IDS
            LAS unsigned char* Kl = lds; LAS unsigned char* Vl = lds + 2 * 128 * S64; LAS float* lutl = (LAS float*)(lds + 4 * 128 * S64);
            const int i = lane & 15, g4 = lane >> 4, hh = wave >> 2, ct = wave & 3;
            const int cbase = ct == 0 ? 0 : (ct == 1 ? 8 : (ct == 2 ? 24 : 32));
            const float* rpb = P.in[I_RPB] + (size_t)l * 4 * 465;
            for (int e = tid; e < 1860; e += NTHR) lutl[e] = rpb[e] * LOG2E;
            int bid2 = bid; asm volatile("" : "+s"(bid2));
            const int per = (2048 + G - 1) / G, u0 = min(bid2 * per, 2047), u1 = min(bid2 * per + per, 2048), nf = (u1 - u0) * 4;
            const int qc = 16 * ct + i, cs = min(max(qc - 8, 0), 48);
            u32x4 pk[4], pvv[4], pq[2];
            auto issue = [&](int f) {
                const int unit = u0 + (f >> 2), c = f & 3, b = unit >> 7, rr = (unit >> 1) & 63, hp = unit & 1;
                const int r0 = min(max(rr - 4, 0), 56), tk0 = (r0 + 2 * c) * 64;
                const bf16_t* zb = Z + (size_t)b * SEQ * ZLD;
#pragma unroll
                for (int it = 0; it < 4; ++it) {
                    const int e = tid + NTHR * it, h2 = e >> 10, row = (e >> 3) & 127, ch = e & 7;
                    const bf16_t* src = zb + (size_t)(tk0 + row) * ZLD + 64 * (2 * hp + h2) + 8 * ch;
                    pk[it] = *(const u32x4*)(src + ZC_KA); pvv[it] = *(const u32x4*)(src + ZC_VA);
                }
                if (c == 0) { const bf16_t* qp = zb + (size_t)(rr * 64 + qc) * ZLD + ZC_QA + 64 * (2 * hp + hh) + 8 * g4; pq[0] = *(const u32x4*)qp; pq[1] = *(const u32x4*)(qp + 32); }
            };
            auto commit = [&]() {
#pragma unroll
                for (int it = 0; it < 4; ++it) { const int e = tid + NTHR * it, h2 = e >> 10, row = (e >> 3) & 127, ch = e & 7;
                    *(LAS u32x4*)(Kl + (h2 * 128 + row) * S64 + ch * 16) = pk[it]; *(LAS u32x4*)(Vl + (h2 * 128 + row) * S64 + ch * 16) = pvv[it]; }
            };
            bf16x8 qf[1][2]; f32x4 o[1][4]; float mr[1] = {0.f}, lr[1] = {0.f};
            qf[0][0] = (bf16x8){0, 0, 0, 0, 0, 0, 0, 0}; qf[0][1] = qf[0][0];
#pragma unroll
            for (int db = 0; db < 4; ++db) o[0][db] = (f32x4){0.f, 0.f, 0.f, 0.f};
            issue(0);
            for (int f = 0; f < nf; ++f) {
                const int unit = u0 + (f >> 2), c = f & 3, b = unit >> 7, rr = (unit >> 1) & 63, hp = unit & 1, head = 2 * hp + hh;
                const int r0 = min(max(rr - 4, 0), 56);
                commit();
                if (c == 0) {
                    qf[0][0] = __builtin_bit_cast(bf16x8, scale_bf8(pq[0], 0.125f * LOG2E)); qf[0][1] = __builtin_bit_cast(bf16x8, scale_bf8(pq[1], 0.125f * LOG2E));
                    mr[0] = 0.f; lr[0] = 0.f;
#pragma unroll
                    for (int db = 0; db < 4; ++db) o[0][db] = (f32x4){0.f, 0.f, 0.f, 0.f};
                }
                __syncthreads();
                if (f + 1 < nf) issue(f + 1);
#pragma unroll
                for (int kr = 0; kr < 2; ++kr) {
                    const int dr = (r0 + 2 * c + kr) - rr + 7;
                    const LAS float* lrow = lutl + head * 465 + dr * 31;
                    auto bm = [&](f32x4& s0, f32x4& s1, int, int) {
#pragma unroll
                        for (int j = 0; j < 4; ++j) {
                            { const int kc = cbase + 4 * g4 + j; const bool ok = (kc >= cs) && (kc < cs + 16); const int idx = min(max(kc - qc + 15, 0), 30);
                              s0[j] = ok ? s0[j] + lrow[idx] : -INFINITY; }
                            { const int kc = cbase + 16 + 4 * g4 + j; const bool ok = (kc >= cs) && (kc < cs + 16); const int idx = min(max(kc - qc + 15, 0), 30);
                              s1[j] = ok ? s1[j] + lrow[idx] : -INFINITY; }
                        }
                    };
                    attn_step<2, 1, S64>(Kl + hh * 128 * S64, Vl + hh * 128 * S64, kr * 64 + cbase, qf, o, mr, lr, lane, bm);
                }
                if (c == 3) {
                    float lt = lr[0]; lt += __shfl_xor(lt, 16); lt += __shfl_xor(lt, 32);
                    const float inv = 1.0f / lt;
                    bf16_t* op = OB + ((size_t)b * SEQ + rr * 64 + qc) * DM + 64 * head + 4 * g4;
#pragma unroll
                    for (int db = 0; db < 4; ++db) { u32x2 w; w.x = pk2(o[0][db][0] * inv, o[0][db][1] * inv); w.y = pk2(o[0][db][2] * inv, o[0][db][3] * inv); *(u32x2*)(op + 16 * db) = w; }
                }
                __syncthreads();
            }
        }
        { LOCAL_IDS
        const int h = lane >> 3;
        for (int row0 = gw; row0 < MTOK; row0 += 4 * NGW) {
            u32x4 pa[4], pb_[4], pc[4]; float l0[4], l1[4], l2[4];
#pragma unroll
            for (int r = 0; r < 4; ++r) { const size_t row = (size_t)(row0 + r * NGW);
                l0[r] = lse[((size_t)0 * MTOK + row) * 8 + h]; l1[r] = lse[((size_t)1 * MTOK + row) * 8 + h]; l2[r] = lse[((size_t)2 * MTOK + row) * 8 + h];
                pa[r] = *(const u32x4*)(PART + ((size_t)0 * MTOK + row) * 512 + 8 * lane);
                pb_[r] = *(const u32x4*)(PART + ((size_t)1 * MTOK + row) * 512 + 8 * lane);
                pc[r] = *(const u32x4*)(PART + ((size_t)2 * MTOK + row) * 512 + 8 * lane); }
#pragma unroll
            for (int r = 0; r < 4; ++r) {
                const float mx = fmaxf(l0[r], fmaxf(l1[r], l2[r]));
                float w0 = __builtin_amdgcn_exp2f(l0[r] - mx), w1 = __builtin_amdgcn_exp2f(l1[r] - mx), w2 = __builtin_amdgcn_exp2f(l2[r] - mx);
                const float inv = 1.0f / (w0 + w1 + w2); w0 *= inv; w1 *= inv; w2 *= inv;
                const u32x4 a = pa[r], bq = pb_[r], cq = pc[r];
                u32x4 o;
                o.x = pk2(w0 * bflo(a.x) + w1 * bflo(bq.x) + w2 * bflo(cq.x), w0 * bfhi(a.x) + w1 * bfhi(bq.x) + w2 * bfhi(cq.x));
                o.y = pk2(w0 * bflo(a.y) + w1 * bflo(bq.y) + w2 * bflo(cq.y), w0 * bfhi(a.y) + w1 * bfhi(bq.y) + w2 * bfhi(cq.y));
                o.z = pk2(w0 * bflo(a.z) + w1 * bflo(bq.z) + w2 * bflo(cq.z), w0 * bfhi(a.z) + w1 * bfhi(bq.z) + w2 * bfhi(cq.z));
                o.w = pk2(w0 * bflo(a.w) + w1 * bflo(bq.w) + w2 * bflo(cq.w), w0 * bfhi(a.w) + w1 * bfhi(bq.w) + w2 * bfhi(cq.w));
                *(u32x4*)(OB + (size_t)(row0 + r * NGW) * DM + 256 + 8 * lane) = o;
            }
        } }
        GSYNC();
        {
            pg8::Gemm g{OB, (const bf16_t*)(wl + WL_OUT), MTOK, DM, DM, DM}; pg8::StaticOrder S; S.init(MTOK, DM, G, bid);
            pg8::EpiStore16 E{YMIX, DM};
            pg8::gemm_phase(lds, g, S, E);
        }
        GSYNC();
        { LOCAL_IDS
        for (int row = gw; row < MTOK; row += 4 * NGW)
            rowwise_rows<4>(row, NGW, (l == 0 ? P.in[I_X] : P.out), YMIX, P.in[I_GPOSTMIX] + l * DM, 2048, modl, P.out, P.in[I_GPREFFN] + l * DM, 4096, 3072, XN, lane);
        }
        GSYNC();
        {
            pg8::Gemm g{XN, (const bf16_t*)(wl + WL_UP) + (size_t)DFF * DM, MTOK, DFF, DM, DM}; pg8::StaticOrder S; S.init(MTOK, DFF, G, bid);
            pg8::EpiStore16 E{GB, DFF};
            pg8::gemm_phase(lds, g, S, E);
        }
        GSYNC();
        {
            pg8::Gemm g{XN, (const bf16_t*)(wl + WL_UP), MTOK, DFF, DM, DM}; pg8::StaticOrder S; S.init(MTOK, DFF, G, bid);
            pg8::EpiGate E{HID, GB, P.in[I_CONVW] + (size_t)l * 3 * DFF, P.in[I_CONVB] + (size_t)l * DFF};
            pg8::gemm_phase(lds, g, S, E);
        }
        GSYNC();
        {
            pg8::Gemm g{HID, (const bf16_t*)(wl + WL_DOWN), MTOK, DM, DFF, DFF}; pg8::StaticOrder S; S.init(MTOK, DM, G, bid);
            pg8::EpiStore16 E{YFFN, DM};
            pg8::gemm_phase(lds, g, S, E);
        }
        GSYNC();
        { LOCAL_IDS
        const int ln = (l + 1 < DEPTH) ? l + 1 : l;
        for (int row = gw; row < MTOK; row += 4 * NGW)
            rowwise_rows<4>(row, NGW, P.out, YFFN, P.in[I_GPOSTFFN] + l * DM, 5120, modl, P.out, P.in[I_GPREMIX] + ln * DM, (ln - l) * 16 * 6144 + 1024, (ln - l) * 16 * 6144, (l + 1 < DEPTH) ? XN : nullptr, lane);
        }
        if (l + 1 < DEPTH) GSYNC();
    }
}

extern "C" void kernel_launch(void* const* d_in, const int* in_sizes, int n_in, void* d_out, int out_size, void* d_ws, size_t ws_size, hipStream_t stream) {
    static int grid_blocks = 0;
    if (grid_blocks == 0) {
        if (n_in != 20 || ws_size < WS_END) { fprintf(stderr, "kernel_launch: unexpected n_in %d or ws_size %zu\n", n_in, ws_size); grid_blocks = -1; return; }
        int dev = 0, cus = 0, per_cu = 0;
        hipGetDevice(&dev);
        hipDeviceGetAttribute(&cus, hipDeviceAttributeMultiprocessorCount, dev);
        if (hipFuncSetAttribute((const void*)fwd_megakernel, hipFuncAttributeMaxDynamicSharedMemorySize, LDS_BYTES) != hipSuccess) fprintf(stderr, "kernel_launch: hipFuncSetAttribute failed\n");
        hipOccupancyMaxActiveBlocksPerMultiprocessor(&per_cu, (const void*)fwd_megakernel, NTHR, LDS_BYTES);
        (void)hipGetLastError();
        if (per_cu < 1) { fprintf(stderr, "kernel_launch: occupancy query gives %d\n", per_cu); per_cu = 1; }
        grid_blocks = cus;
    }
    if (grid_blocks < 0) return;
    Params p{};
    for (int i = 0; i < 20; ++i) p.in[i] = (const float*)d_in[i];
    p.out = (float*)d_out; p.ws = (unsigned char*)d_ws;
    void* args[] = {&p};
    hipError_t e = hipLaunchCooperativeKernel((const void*)fwd_megakernel, dim3(grid_blocks), dim3(NTHR), args, LDS_BYTES, stream);
    if (e != hipSuccess) fprintf(stderr, "cooperative launch failed: %s (grid %d)\n", hipGetErrorString(e), grid_blocks);
}
```

```cpp
#include <hip/hip_runtime.h>
#include <hip/hip_cooperative_groups.h>
#include <cstdint>
#include <cstdio>
namespace cg = cooperative_groups;

#define LAS __attribute__((address_space(3)))
typedef unsigned short bf16_t;
typedef short bf16x8 __attribute__((ext_vector_type(8)));
typedef short s16x4 __attribute__((ext_vector_type(4)));
typedef float f32x4 __attribute__((ext_vector_type(4)));
typedef float f32x2 __attribute__((ext_vector_type(2)));
typedef unsigned u32x4 __attribute__((ext_vector_type(4)));
typedef unsigned u32x2 __attribute__((ext_vector_type(2)));
typedef __bf16 bf16x2_t __attribute__((ext_vector_type(2)));

constexpr int DM = 1024, NB = 16, SEQ = 4096, MTOK = NB * SEQ, DEPTH = 4;
constexpr int DIN = 2976, ZLD = 3072, DFF = 2816;
constexpr int ZC_QA = 0, ZC_KA = 256, ZC_VA = 512, ZC_QB = 768, ZC_KB = 1280, ZC_VB = 1792, ZC_CQ = 2304, ZC_CKV = 2688, ZC_KR = 2944;
constexpr float EPS = 1e-6f, LOG2E = 1.4426950408889634f;
constexpr int NTHR = 512, NWAVE = 8;
constexpr int S64 = 160, S96 = 224;

constexpr size_t MiB = 1u << 20;
constexpr size_t WS_MOD = 0;
constexpr size_t WS_BAR = MiB + 768 * 1024;
constexpr size_t WS_ROPE = 2 * MiB;
constexpr size_t WS_RQ = 3 * MiB;
constexpr size_t WS_LUT = 3 * MiB + 512 * 1024;
constexpr size_t WS_LSE = 4 * MiB;
constexpr size_t WS_W = 16 * MiB;
constexpr size_t WL_STRIDE = 26 * MiB;
constexpr size_t WL_IN = 0, WL_OUT = 6 * MiB, WL_UP = 8 * MiB, WL_DOWN = 19 * MiB, WL_UQ = 24 * MiB + 512 * 1024, WL_UKV = 25 * MiB;
constexpr size_t WS_XN = 120 * MiB;
constexpr size_t WS_Z = 248 * MiB;
constexpr size_t WS_Q = 632 * MiB;
constexpr size_t WS_KV = 680 * MiB;
constexpr size_t WS_PART = 744 * MiB;
constexpr size_t WS_G = 248 * MiB;
constexpr size_t WS_HID = 600 * MiB;
constexpr size_t WS_XSLOT = 952 * MiB;
constexpr size_t WS_XCNT = 968 * MiB;
constexpr size_t WS_END = 969 * MiB;

__device__ __forceinline__ unsigned pk2(float lo, float hi) { f32x2 v = {lo, hi}; bf16x2_t b = __builtin_convertvector(v, bf16x2_t); return __builtin_bit_cast(unsigned, b); }
__device__ __forceinline__ float bflo(unsigned u) { return __uint_as_float(u << 16); }
__device__ __forceinline__ float bfhi(unsigned u) { return __uint_as_float(u & 0xffff0000u); }
__device__ __forceinline__ int flat_tid(int wave_s) { unsigned z = 0u; asm volatile("" : "+v"(z));
    return wave_s * 64 + (int)__builtin_amdgcn_mbcnt_hi(~0u, __builtin_amdgcn_mbcnt_lo(~0u, z)); }
__device__ __forceinline__ float wave_sum(float v) {
#pragma unroll
    for (int o = 1; o < 64; o <<= 1) v += __shfl_xor(v, o);
    return v;
}
__device__ __forceinline__ u32x4 scale_bf8(u32x4 v, float s) {
    u32x4 r;
    r.x = pk2(bflo(v.x) * s, bfhi(v.x) * s); r.y = pk2(bflo(v.y) * s, bfhi(v.y) * s);
    r.z = pk2(bflo(v.z) * s, bfhi(v.z) * s); r.w = pk2(bflo(v.w) * s, bfhi(v.w) * s);
    return r;
}

namespace pg8 {
constexpr int BM = 256, BK = 64, HALF = 128, HTB = HALF * BK * 2, STAGE_BYTES = 8 * HTB, NXCD = 8, WGM = 8;
__device__ __forceinline__ int lds_byte(int r, int c) { const int st = (r >> 4) * 2 + (c >> 5), rr = r & 15, cc = c & 31, ob = rr * 64 + cc * 2; return st * 1024 + (ob ^ (((ob >> 9) & 1) << 5)); }
__device__ __forceinline__ void stage_rc(int b, int& R, int& C) { const int st = b / 1024, sb = b % 1024, swz = sb ^ (((sb >> 9) & 1) << 5); R = (st >> 1) * 16 + swz / 64; C = (st & 1) * 32 + (swz % 64) / 2; }

__device__ __forceinline__ int perm32(int rho) { const int n = rho >> 4, i = rho & 15; return 8 * (i >> 2) + 4 * n + (i & 3); }
struct Unit { int pm, pn; };
struct Gemm { const bf16_t* A; const bf16_t* Bt; int M, N, K, lda; };

struct StaticOrder {
    int nM, nN, nwg, G, c;
    __device__ void init(int M, int N, int G_, int c_) { nM = M / BM; nN = N / BM; nwg = nM * nN; G = G_; c = c_; }
    __device__ bool next(int i, Unit& u) const {
        const long L = (long)i * G + c; if (L >= nwg) return false;
        int wgid = (int)L; { const int q = nwg / NXCD, r = nwg % NXCD, xcd = wgid % NXCD, off = wgid / NXCD; wgid = (xcd < r ? xcd * (q + 1) : r * (q + 1) + (xcd - r) * q) + off; }
        const int nig = WGM * nN, gid = wgid / nig, fm = gid * WGM, gsz = (nM - fm) < WGM ? (nM - fm) : WGM;
        u.pm = fm + ((wgid % nig) % gsz); u.pn = (wgid % nig) / gsz; return true;
    }
};

template <class Epi>
__device__ __forceinline__ void gemm_phase(LAS unsigned char* lds, const Gemm g, const StaticOrder& S, const Epi& E, int wave_s) {
    int tid = flat_tid(wave_s); asm volatile("" : "+v"(tid));
    const int wid = __builtin_amdgcn_readfirstlane(tid >> 6), lane = tid & 63, wr = wid >> 2, wc = wid & 3, fr = lane & 15, fq = lane >> 4;
    const int K = g.K, nt = K / BK, lda = g.lda;
    unsigned voffA[2], voffB[2];
#pragma unroll
    for (int i = 0; i < 2; ++i) { int R, C; stage_rc(tid * 16 + i * 8192, R, C);
        const int Rb = Epi::PERM ? ((R & ~31) + perm32(R & 31)) : R;
        voffA[i] = (unsigned)(R * lda + C) * 2u; voffB[i] = (unsigned)(Rb * K + C) * 2u; }
    const size_t kstep = (size_t)(BK * 2);
    const size_t hstepA = (size_t)HALF * lda * 2, hstepB = (size_t)HALF * K * 2;
    const size_t tstepA = 2 * hstepA, tstepB = 2 * hstepB;
    const unsigned ldsw = (unsigned)wid * 1024u;
    const int aoff = lds_byte(wr * 64 + fr, fq * 8), boff = lds_byte(wc * 32 + fr, fq * 8);
#define PG8_SA(b, h) (((b) * 2 + (h)) * HTB)
#define PG8_SB(b, h) ((4 + (b) * 2 + (h)) * HTB)
#define PG8_STAGE(bufoff, gbase, voff) do { _Pragma("unroll") for (int _i = 0; _i < 2; ++_i) \
        __builtin_amdgcn_global_load_lds((const unsigned*)((const char*)(gbase) + (voff)[_i]), (LAS unsigned*)(lds + (bufoff) + ldsw + _i * 8192), 16, 0, 0); } while (0)
#define PG8_LDA(dst, b, h) do { _Pragma("unroll") for (int m = 0; m < 4; ++m) _Pragma("unroll") for (int k = 0; k < 2; ++k) dst[m][k] = *(const LAS bf16x8*)(lds + PG8_SA(b, h) + aoff + m * 2048 + k * 1024); } while (0)
#define PG8_LDB(dst, b, h) do { _Pragma("unroll") for (int n = 0; n < 2; ++n) _Pragma("unroll") for (int k = 0; k < 2; ++k) dst[n][k] = *(const LAS bf16x8*)(lds + PG8_SB(b, h) + boff + n * 2048 + k * 1024); } while (0)
#define PG8_MMA(ai, bj, At, Bt) do { __builtin_amdgcn_s_setprio(1); _Pragma("unroll") for (int m = 0; m < 4; ++m) _Pragma("unroll") for (int n = 0; n < 2; ++n) _Pragma("unroll") for (int k = 0; k < 2; ++k) \
        acc[ai][bj][m][n] = __builtin_amdgcn_mfma_f32_16x16x32_bf16(Bt[n][k], At[m][k], acc[ai][bj][m][n], 0, 0, 0); __builtin_amdgcn_s_setprio(0); } while (0)
#define PG8_WAIT_V(n) asm volatile("s_waitcnt vmcnt(" #n ")" ::: "memory")
#define PG8_WAIT_L(n) asm volatile("s_waitcnt lgkmcnt(" #n ")" ::: "memory")
#define PG8_BAR __builtin_amdgcn_s_barrier()
#define PG8_SCHED __builtin_amdgcn_sched_barrier(0)
    Unit cur, nxt; int ui = 0;
    if (!S.next(0, cur)) return;
    f32x4 acc[2][2][4][2];
#pragma unroll
    for (int a = 0; a < 2; ++a)
#pragma unroll
        for (int b = 0; b < 2; ++b)
#pragma unroll
            for (int m = 0; m < 4; ++m)
#pragma unroll
                for (int n = 0; n < 2; ++n) acc[a][b][m][n] = (f32x4){0.f, 0.f, 0.f, 0.f};
    bf16x8 At[4][2], B0[2][2], B1[2][2];
    const char* cA = (const char*)g.A + (size_t)cur.pm * tstepA; const char* cB = (const char*)g.Bt + (size_t)cur.pn * tstepB;
    PG8_STAGE(PG8_SB(0, 0), cB, voffB); PG8_STAGE(PG8_SB(0, 1), cB + hstepB, voffB); PG8_STAGE(PG8_SA(0, 0), cA, voffA); PG8_STAGE(PG8_SA(0, 1), cA + hstepA, voffA);
    if (wr == 1) PG8_BAR;
    PG8_WAIT_V(2); PG8_BAR;
    PG8_STAGE(PG8_SB(1, 0), cB + kstep, voffB); PG8_STAGE(PG8_SA(1, 0), cA + kstep, voffA); PG8_STAGE(PG8_SB(1, 1), cB + hstepB + kstep, voffB);
    PG8_WAIT_V(6); PG8_BAR;
    for (;;) {
        const bool has_next = S.next(ui + 1, nxt);
        const char* nA = has_next ? (const char*)g.A + (size_t)nxt.pm * tstepA : cA; const char* nB = has_next ? (const char*)g.Bt + (size_t)nxt.pn * tstepB : cB;
        for (int t = 0; t < nt; t += 2) {
            const bool last = (t == nt - 2);
            const char* a1 = cA + (size_t)(t + 1) * kstep;
            const char* a2 = last ? nA : cA + (size_t)(t + 2) * kstep; const char* b2 = last ? nB : cB + (size_t)(t + 2) * kstep;
            const char* a3 = a2 + kstep; const char* b3 = b2 + kstep;
            PG8_LDB(B0, 0, 0); PG8_LDB(B1, 0, 1); PG8_SCHED; PG8_LDA(At, 0, 0); PG8_STAGE(PG8_SA(1, 1), a1 + hstepA, voffA);
            PG8_WAIT_V(8); PG8_WAIT_L(0); PG8_BAR; PG8_MMA(0, 0, At, B0); PG8_MMA(0, 1, At, B1); PG8_BAR; PG8_SCHED;
            PG8_LDA(At, 0, 1); PG8_STAGE(PG8_SB(0, 0), b2, voffB); PG8_STAGE(PG8_SB(0, 1), b2 + hstepB, voffB); PG8_STAGE(PG8_SA(0, 0), a2, voffA);
            PG8_WAIT_V(8); PG8_WAIT_L(0); PG8_BAR; PG8_MMA(1, 0, At, B0); PG8_MMA(1, 1, At, B1); PG8_BAR; PG8_SCHED;
            PG8_LDB(B0, 1, 0); PG8_LDB(B1, 1, 1); PG8_SCHED; PG8_LDA(At, 1, 0); PG8_STAGE(PG8_SA(0, 1), a2 + hstepA, voffA);
            PG8_WAIT_V(8); PG8_WAIT_L(0); PG8_BAR; PG8_MMA(0, 0, At, B0); PG8_MMA(0, 1, At, B1); PG8_BAR; PG8_SCHED;
            PG8_LDA(At, 1, 1); PG8_STAGE(PG8_SB(1, 0), b3, voffB); PG8_STAGE(PG8_SB(1, 1), b3 + hstepB, voffB); PG8_STAGE(PG8_SA(1, 0), a3, voffA);
            PG8_WAIT_V(8); PG8_WAIT_L(0); PG8_BAR; PG8_MMA(1, 0, At, B0); PG8_MMA(1, 1, At, B1); PG8_BAR; PG8_SCHED;
        }
        if (wr == 0) PG8_BAR;
        E(acc, cur, wr, wc, fr, fq);
        if (!has_next) break;
#pragma unroll
        for (int a = 0; a < 2; ++a)
#pragma unroll
            for (int b = 0; b < 2; ++b)
#pragma unroll
                for (int m = 0; m < 4; ++m)
#pragma unroll
                    for (int n = 0; n < 2; ++n) acc[a][b][m][n] = (f32x4){0.f, 0.f, 0.f, 0.f};
        cur = nxt; cA = nA; cB = nB; ++ui;
        if (wr == 1) PG8_BAR;
    }
    PG8_WAIT_V(0);
    PG8_BAR;
#undef PG8_SA
#undef PG8_SB
#undef PG8_STAGE
#undef PG8_LDA
#undef PG8_LDB
#undef PG8_MMA
#undef PG8_WAIT_V
#undef PG8_WAIT_L
#undef PG8_BAR
#undef PG8_SCHED
}

struct EpiStore16 {
    static constexpr bool PERM = true;
    bf16_t* O; int ldc;
    __device__ __forceinline__ void operator()(const f32x4 (&acc)[2][2][4][2], const Unit& u, int wr, int wc, int fr, int fq) const {
#pragma unroll
        for (int ai = 0; ai < 2; ++ai)
#pragma unroll
            for (int m = 0; m < 4; ++m) {
                bf16_t* rowp = O + (size_t)(u.pm * BM + ai * HALF + wr * 64 + m * 16 + fr) * ldc + u.pn * BM + wc * 32 + 8 * fq;
#pragma unroll
                for (int bj = 0; bj < 2; ++bj) { const f32x4 v0 = acc[ai][bj][m][0], v1 = acc[ai][bj][m][1];
                    u32x4 w; w.x = pk2(v0[0], v0[1]); w.y = pk2(v0[2], v0[3]); w.z = pk2(v1[0], v1[1]); w.w = pk2(v1[2], v1[3]);
                    *(u32x4*)(rowp + bj * HALF) = w; }
            }
    }
};
struct EpiStore {
    static constexpr bool PERM = true;
    bf16_t* O; int ldc; int ncols; int rope_mode; const float* cosT; const float* sinT;
    __device__ __forceinline__ void operator()(const f32x4 (&acc)[2][2][4][2], const Unit& u, int wr, int wc, int fr, int fq) const {
#pragma unroll
        for (int bj = 0; bj < 2; ++bj) {
            const int cg0 = u.pn * BM + bj * HALF + wc * 32;
            if (cg0 >= ncols) continue;
            const bool rope = (rope_mode == 1) ? (cg0 == ZC_KR) : (rope_mode == 2 ? (((cg0 >> 5) % 3) == 2) : false);
#pragma unroll
            for (int ai = 0; ai < 2; ++ai)
#pragma unroll
                for (int m = 0; m < 4; ++m) {
                    const int row = u.pm * BM + ai * HALF + wr * 64 + m * 16 + fr;
                    f32x4 v0 = acc[ai][bj][m][0], v1 = acc[ai][bj][m][1];
                    if (rope) {
                        const int s = row & (SEQ - 1), ib = 8 * (fq & 1);
                        const f32x4 c0 = *(const f32x4*)(cosT + s * 16 + ib), c1 = *(const f32x4*)(cosT + s * 16 + ib + 4);
                        const f32x4 s0 = *(const f32x4*)(sinT + s * 16 + ib), s1 = *(const f32x4*)(sinT + s * 16 + ib + 4);
                        f32x4 p0, p1;
#pragma unroll
                        for (int e = 0; e < 4; ++e) { p0[e] = __shfl_xor(v0[e], 32); p1[e] = __shfl_xor(v1[e], 32); }
                        if (fq < 2) { v0 = v0 * c0 - p0 * s0; v1 = v1 * c1 - p1 * s1; }
                        else        { v0 = p0 * s0 + v0 * c0; v1 = p1 * s1 + v1 * c1; }
                    }
                    u32x4 w; w.x = pk2(v0[0], v0[1]); w.y = pk2(v0[2], v0[3]); w.z = pk2(v1[0], v1[1]); w.w = pk2(v1[2], v1[3]);
                    *(u32x4*)(O + (size_t)row * ldc + cg0 + 8 * fq) = w;
                }
        }
    }
};

struct EpiNorm {
    static constexpr bool PERM = true;
    const float* xin; float* xout; bf16_t* XN;
    const float* gpost; const float* gpre; const float* modb; int gate_off, sc_off, sh_off;
    float* slot1; unsigned* cnt1; float* slot2; unsigned* cnt2;
    LAS unsigned char* xl;
    __device__ __forceinline__ void rowstat(const f32x4 (&v)[2][2][4][2], const Unit& u, int wr, int wc, int fr, int fq, float* slot, unsigned* cnt) const {
        LAS float* Pp = (LAS float*)xl; LAS float* S = (LAS float*)(xl + 4096);
        const int wid = wr * 4 + wc, tid = wid * 64 + fq * 16 + fr;
#pragma unroll
        for (int ai = 0; ai < 2; ++ai)
#pragma unroll
            for (int m = 0; m < 4; ++m) {
                float ss = 0.f;
#pragma unroll
                for (int bj = 0; bj < 2; ++bj)
#pragma unroll
                    for (int n = 0; n < 2; ++n) { const f32x4 x = v[ai][bj][m][n]; ss += (x[0] * x[0] + x[1] * x[1]) + (x[2] * x[2] + x[3] * x[3]); }
                ss += __shfl_xor(ss, 16); ss += __shfl_xor(ss, 32);
                if (fq == 0) Pp[(ai * HALF + wr * 64 + m * 16 + fr) * 4 + wc] = ss;
            }
        asm volatile("s_waitcnt lgkmcnt(0)" ::: "memory"); __builtin_amdgcn_s_barrier(); asm volatile("" ::: "memory");
        if (tid < 256) {
            const float tot = (Pp[tid * 4 + 0] + Pp[tid * 4 + 1]) + (Pp[tid * 4 + 2] + Pp[tid * 4 + 3]);
            __hip_atomic_store(slot + ((size_t)u.pm * BM + tid) * 4 + u.pn, tot, __ATOMIC_RELAXED, __HIP_MEMORY_SCOPE_AGENT);
        }
        asm volatile("s_waitcnt vmcnt(0)" ::: "memory");
        if (wid < 4 && (tid & 63) == 0) __hip_atomic_fetch_add(cnt + 64 * u.pm, 1u, __ATOMIC_RELAXED, __HIP_MEMORY_SCOPE_AGENT);
        if (wid == 0) {
            unsigned sp = 0;
            while ((unsigned)__builtin_amdgcn_readfirstlane(__hip_atomic_load(cnt + 64 * u.pm, __ATOMIC_RELAXED, __HIP_MEMORY_SCOPE_AGENT)) < 16u) { __builtin_amdgcn_s_sleep(2); if (++sp > (1u << 20)) break; }
            __builtin_amdgcn_fence(__ATOMIC_ACQUIRE, "agent");
        }
        asm volatile("s_waitcnt vmcnt(0) lgkmcnt(0)" ::: "memory"); __builtin_amdgcn_s_barrier(); asm volatile("" ::: "memory");
        if (tid < 256) {
            const float* sp4 = slot + ((size_t)u.pm * BM + tid) * 4;
            const float t0 = __hip_atomic_load(sp4 + 0, __ATOMIC_RELAXED, __HIP_MEMORY_SCOPE_AGENT), t1 = __hip_atomic_load(sp4 + 1, __ATOMIC_RELAXED, __HIP_MEMORY_SCOPE_AGENT);
            const float t2 = __hip_atomic_load(sp4 + 2, __ATOMIC_RELAXED, __HIP_MEMORY_SCOPE_AGENT), t3 = __hip_atomic_load(sp4 + 3, __ATOMIC_RELAXED, __HIP_MEMORY_SCOPE_AGENT);
            S[tid] = rsqrtf(((t0 + t1) + (t2 + t3)) * (1.0f / DM) + EPS);
        }
        asm volatile("s_waitcnt vmcnt(0) lgkmcnt(0)" ::: "memory"); __builtin_amdgcn_s_barrier(); asm volatile("" ::: "memory");
    }
    __device__ __forceinline__ void operator()(f32x4 (&acc)[2][2][4][2], const Unit& u, int wr, int wc, int fr, int fq) const {
        const LAS float* S = (const LAS float*)(xl + 4096);
        const float* md = modb + (size_t)(u.pm >> 4) * 6144;
        rowstat(acc, u, wr, wc, fr, fq, slot1, cnt1);
#pragma unroll
        for (int bj = 0; bj < 2; ++bj)
#pragma unroll
            for (int n = 0; n < 2; ++n) {
                const int col = u.pn * BM + bj * HALF + wc * 32 + 8 * fq + 4 * n;
                const f32x4 gg = *(const f32x4*)(md + gate_off + col) * *(const f32x4*)(gpost + col);
#pragma unroll
                for (int ai = 0; ai < 2; ++ai)
#pragma unroll
                    for (int m = 0; m < 4; ++m) {
                        const int rl = ai * HALF + wr * 64 + m * 16 + fr; const size_t off = (size_t)(u.pm * BM + rl) * DM + col;
                        const f32x4 xv = *(const f32x4*)(xin + off);
                        const f32x4 xn = xv + gg * (acc[ai][bj][m][n] * S[rl]);
                        acc[ai][bj][m][n] = xn; *(f32x4*)(xout + off) = xn;
                    }
            }
        if (XN == nullptr) return;
        asm volatile("s_waitcnt lgkmcnt(0)" ::: "memory"); __builtin_amdgcn_s_barrier(); asm volatile("" ::: "memory");
        rowstat(acc, u, wr, wc, fr, fq, slot2, cnt2);
#pragma unroll
        for (int bj = 0; bj < 2; ++bj) {
            const int col = u.pn * BM + bj * HALF + wc * 32 + 8 * fq;
            f32x4 mp[2], sh[2];
#pragma unroll
            for (int n = 0; n < 2; ++n) { mp[n] = *(const f32x4*)(gpre + col + 4 * n) * (*(const f32x4*)(md + sc_off + col + 4 * n) + 1.0f); sh[n] = *(const f32x4*)(md + sh_off + col + 4 * n); }
#pragma unroll
            for (int ai = 0; ai < 2; ++ai)
#pragma unroll
                for (int m = 0; m < 4; ++m) {
                    const int rl = ai * HALF + wr * 64 + m * 16 + fr; const float r = S[rl];
                    const f32x4 h0 = (acc[ai][bj][m][0] * r) * mp[0] + sh[0], h1 = (acc[ai][bj][m][1] * r) * mp[1] + sh[1];
                    u32x4 w; w.x = pk2(h0[0], h0[1]); w.y = pk2(h0[2], h0[3]); w.z = pk2(h1[0], h1[1]); w.w = pk2(h1[2], h1[3]);
                    *(u32x4*)(XN + (size_t)(u.pm * BM + rl) * DM + col) = w;
                }
        }
        asm volatile("s_waitcnt lgkmcnt(0)" ::: "memory"); __builtin_amdgcn_s_barrier(); asm volatile("" ::: "memory");
    }
};

struct EpiGate {
    static constexpr bool PERM = true;
    bf16_t* H; const bf16_t* G; const float* cw; const float* cb;
    __device__ __forceinline__ void operator()(const f32x4 (&acc)[2][2][4][2], const Unit& u, int wr, int wc, int fr, int fq) const {
#pragma unroll
        for (int bj = 0; bj < 2; ++bj) {
            const int col = u.pn * BM + bj * HALF + wc * 32 + 8 * fq;
            f32x4 w0[2], w1[2], w2[2], bb[2];
#pragma unroll
            for (int n = 0; n < 2; ++n) { w0[n] = *(const f32x4*)(cw + col + 4 * n); w1[n] = *(const f32x4*)(cw + DFF + col + 4 * n); w2[n] = *(const f32x4*)(cw + 2 * DFF + col + 4 * n); bb[n] = *(const f32x4*)(cb + col + 4 * n); }
#pragma unroll
            for (int ai = 0; ai < 2; ++ai)
#pragma unroll
                for (int m = 0; m < 4; ++m) {
                    const int row = u.pm * BM + ai * HALF + wr * 64 + m * 16 + fr;
                    const int t = row & (SEQ - 1);
                    const bf16_t* gp = G + (size_t)row * DFF + col;
                    const bool hasm = t > 0, hasn = t < SEQ - 1;
                    u32x4 gm = *(const u32x4*)(gp - (hasm ? DFF : 0));
                    const u32x4 g0 = *(const u32x4*)gp;
                    u32x4 gn = *(const u32x4*)(gp + (hasn ? DFF : 0));
                    const unsigned mm = hasm ? 0xffffffffu : 0u, mn = hasn ? 0xffffffffu : 0u;
                    gm.x &= mm; gm.y &= mm; gm.z &= mm; gm.w &= mm; gn.x &= mn; gn.y &= mn; gn.z &= mn; gn.w &= mn;
                    unsigned ow[4];
#pragma unroll
                    for (int n = 0; n < 2; ++n) {
                        const unsigned m0 = n ? gm.z : gm.x, m1 = n ? gm.w : gm.y, c0 = n ? g0.z : g0.x, c1 = n ? g0.w : g0.y, n0 = n ? gn.z : gn.x, n1 = n ? gn.w : gn.y;
                        const f32x4 fm = {bflo(m0), bfhi(m0), bflo(m1), bfhi(m1)}, f0 = {bflo(c0), bfhi(c0), bflo(c1), bfhi(c1)}, fn = {bflo(n0), bfhi(n0), bflo(n1), bfhi(n1)};
                        const f32x4 gc = bb[n] + fm * w0[n] + f0 * w1[n] + fn * w2[n];
                        const f32x4 a = acc[ai][bj][m][n];
                        float o[4];
#pragma unroll
                        for (int e = 0; e < 4; ++e) {
                            constexpr float C1 = -2.0f * LOG2E * 0.7978845608028654f, C2 = C1 * 0.044715f;
                            const float x = gc[e];
                            const float ex = __builtin_amdgcn_exp2f(x * __builtin_fmaf(x * x, C2, C1));
                            o[e] = (x * a[e]) * __builtin_amdgcn_rcpf(1.0f + ex);
                        }
                        ow[2 * n] = pk2(o[0], o[1]); ow[2 * n + 1] = pk2(o[2], o[3]);
                    }
                    *(u32x4*)(H + (size_t)row * DFF + col) = (u32x4){ow[0], ow[1], ow[2], ow[3]};
                }
        }
    }
};
}

__device__ __forceinline__ s16x4 vtr(LAS const unsigned char* p) { typedef short v4i16_t __attribute__((ext_vector_type(4))); return __builtin_bit_cast(s16x4, __builtin_amdgcn_ds_read_tr16_b64_v4i16((LAS v4i16_t*)p)); }

template <int NK, int NT, int KSTR, class BM>
__device__ __forceinline__ void attn_step(LAS const unsigned char* Kl, LAS const unsigned char* Vl, int kb, const bf16x8 (&q)[NT][NK], f32x4 (&o)[NT][4], float (&mrun)[NT], float (&lrun)[NT], int lane, const BM& bm) {
    constexpr float THR = 8.0f;
    const int i = lane & 15, g = lane >> 4;
    f32x4 s0[NT], s1[NT];
#pragma unroll
    for (int t = 0; t < NT; ++t) { const float nm = -mrun[t]; s0[t] = (f32x4){nm, nm, nm, nm}; s1[t] = s0[t]; }
    LAS const unsigned char* kp = Kl + (kb + i) * KSTR + g * 16;
#pragma unroll
    for (int ks = 0; ks < NK; ++ks) {
        const bf16x8 a0 = *(LAS const bf16x8*)(kp + ks * 64);
        const bf16x8 a1 = *(LAS const bf16x8*)(kp + 16 * KSTR + ks * 64);
#pragma unroll
        for (int t = 0; t < NT; ++t) {
            s0[t] = __builtin_amdgcn_mfma_f32_16x16x32_bf16(a0, q[t][ks], s0[t], 0, 0, 0);
            s1[t] = __builtin_amdgcn_mfma_f32_16x16x32_bf16(a1, q[t][ks], s1[t], 0, 0, 0);
        }
    }
    bf16x8 pb[NT];
#pragma unroll
    for (int t = 0; t < NT; ++t) {
        bm(s0[t], s1[t], kb, t);
        float mx = fmaxf(fmaxf(fmaxf(s0[t][0], s0[t][1]), fmaxf(s0[t][2], s0[t][3])), fmaxf(fmaxf(s1[t][0], s1[t][1]), fmaxf(s1[t][2], s1[t][3])));
        if (__any(mx > THR)) {
            mx = fmaxf(mx, __shfl_xor(mx, 16)); mx = fmaxf(mx, __shfl_xor(mx, 32));
            const float dl = fmaxf(mx, 0.f);
            const float alpha = __builtin_amdgcn_exp2f(-dl);
            mrun[t] += dl; lrun[t] *= alpha;
#pragma unroll
            for (int db = 0; db < 4; ++db) o[t][db] = o[t][db] * alpha;
            s0[t] = s0[t] - dl; s1[t] = s1[t] - dl;
        }
        float p0[4], p1[4]; float ps = 0.f;
#pragma unroll
        for (int j = 0; j < 4; ++j) { p0[j] = __builtin_amdgcn_exp2f(s0[t][j]); p1[j] = __builtin_amdgcn_exp2f(s1[t][j]); ps += p0[j] + p1[j]; }
        lrun[t] += ps;
        u32x4 w; w.x = pk2(p0[0], p0[1]); w.y = pk2(p0[2], p0[3]); w.z = pk2(p1[0], p1[1]); w.w = pk2(p1[2], p1[3]);
        pb[t] = __builtin_bit_cast(bf16x8, w);
    }
    LAS const unsigned char* vp = Vl + (kb + 4 * g + (i >> 2)) * S64 + (i & 3) * 8;
#pragma unroll
    for (int db = 0; db < 4; ++db) {
        const s16x4 lo = vtr(vp + db * 32), hi = vtr(vp + 16 * S64 + db * 32);
        const bf16x8 va = {lo[0], lo[1], lo[2], lo[3], hi[0], hi[1], hi[2], hi[3]};
#pragma unroll
        for (int t = 0; t < NT; ++t) o[t][db] = __builtin_amdgcn_mfma_f32_16x16x32_bf16(va, pb[t], o[t][db], 0, 0, 0);
    }
}

__device__ __forceinline__ bf16x8 load_q(const bf16_t* p, float s) { const u32x4 v = *(const u32x4*)p; return __builtin_bit_cast(bf16x8, scale_bf8(v, s)); }

struct Params { const float* in[20]; float* out; unsigned char* ws; };
enum { I_X = 0, I_C, I_WADA, I_BADA, I_GPREMIX, I_GPOSTMIX, I_GPREFFN, I_GPOSTFFN, I_WIN, I_RPB, I_T5, I_GQ, I_GKV, I_WUQ, I_WUKV, I_WOUT, I_WUP, I_CONVW, I_CONVB, I_WDOWN };

__device__ const unsigned char T5B[3][65] = {
 {0,1,2,3,4,5,6,7,8,8,8,8,8,8,8,9,9,9,9,9,9,9,9,9,9,9,9,10,10,10,10,10,10,10,10,10,10,10,10,10,10,10,10,10,10,10,10,10,10,10,11,11,11,11,11,11,11,11,11,11,11,11,11,11,11},
 {0,4,8,8,9,9,9,10,10,10,10,10,10,11,11,11,11,11,11,11,11,11,11,12,12,12,12,12,12,12,12,12,12,12,12,12,12,12,12,12,12,12,13,13,13,13,13,13,13,13,13,13,13,13,13,13,13,13,13,13,13,13,13,13,13},
 {0,9,10,10,11,11,12,12,12,12,12,13,13,13,13,13,13,13,13,13,14,14,14,14,14,14,14,14,14,14,14,14,14,14,14,15,15,15,15,15,15,15,15,15,15,15,15,15,15,15,15,15,15,15,15,15,15,15,15,15,15,15,15,15,15}};

__device__ __forceinline__ void transpose_item(const float* W, int K, int N, bf16_t* WT, const float* ksc, LAS float* scr, int item, int lane) {
    const int nblk = N / 32, kb = item / nblk, nb = item % nblk, k0 = 64 * kb, n0 = 32 * nb;
#pragma unroll 8
    for (int i = 0; i < 32; ++i) { const int kk = 2 * i + (lane >> 5); float v = W[(size_t)(k0 + kk) * N + n0 + (lane & 31)]; if (ksc) v *= ksc[k0 + kk]; scr[kk * 33 + (lane & 31)] = v; }
    asm volatile("s_waitcnt lgkmcnt(0)" ::: "memory");
    const int c = lane & 7;
#pragma unroll
    for (int j = 0; j < 4; ++j) { const int n = (lane >> 3) + 8 * j; const LAS float* s = scr + (8 * c) * 33 + n;
        u32x4 o; o.x = pk2(s[0 * 33], s[1 * 33]); o.y = pk2(s[2 * 33], s[3 * 33]); o.z = pk2(s[4 * 33], s[5 * 33]); o.w = pk2(s[6 * 33], s[7 * 33]);
        *(u32x4*)(WT + (size_t)(n0 + n) * K + k0 + 8 * c) = o; }
    asm volatile("s_waitcnt lgkmcnt(0)" ::: "memory");
}

template <int R>
__device__ __forceinline__ void rowwise_rows(int row0, int rstride, const float* xin, const bf16_t* y, const float* gpost, int gate_off, const float* modb, float* xout,
                                             const float* gpre, int sc_off, int sh_off, bf16_t* XN, int lane) {
    f32x4 v[R][4]; u32x2 yw[R][4];
#pragma unroll
    for (int r = 0; r < R; ++r) { const size_t ro = (size_t)(row0 + r * rstride) * DM + 4 * lane;
#pragma unroll
        for (int j = 0; j < 4; ++j) v[r][j] = *(const f32x4*)(xin + ro + 256 * j);
        if (y) {
#pragma unroll
            for (int j = 0; j < 4; ++j) yw[r][j] = *(const u32x2*)(y + ro + 256 * j); } }
#pragma unroll
    for (int r = 0; r < R; ++r) {
        const int row = row0 + r * rstride; const size_t ro = (size_t)row * DM + 4 * lane;
        const float* md = modb + (size_t)(row >> 12) * 6144;
        if (y) {
            f32x4 yv[4]; float ss = 0.f;
#pragma unroll
            for (int j = 0; j < 4; ++j) { const u32x2 w = yw[r][j]; yv[j] = (f32x4){bflo(w.x), bfhi(w.x), bflo(w.y), bfhi(w.y)};
                ss += (yv[j][0] * yv[j][0] + yv[j][1] * yv[j][1]) + (yv[j][2] * yv[j][2] + yv[j][3] * yv[j][3]); }
            const float rr = rsqrtf(wave_sum(ss) * (1.0f / DM) + EPS);
#pragma unroll
            for (int j = 0; j < 4; ++j) { const f32x4 gp = *(const f32x4*)(gpost + 4 * lane + 256 * j), gt = *(const f32x4*)(md + gate_off + 4 * lane + 256 * j);
                v[r][j] = v[r][j] + gt * (yv[j] * rr * gp); }
        }
        if (xout) {
#pragma unroll
            for (int j = 0; j < 4; ++j) *(f32x4*)(xout + ro + 256 * j) = v[r][j];
        }
        if (XN) {
            float ss = 0.f;
#pragma unroll
            for (int j = 0; j < 4; ++j) ss += (v[r][j][0] * v[r][j][0] + v[r][j][1] * v[r][j][1]) + (v[r][j][2] * v[r][j][2] + v[r][j][3] * v[r][j][3]);
            const float rr = rsqrtf(wave_sum(ss) * (1.0f / DM) + EPS);
#pragma unroll
            for (int j = 0; j < 4; ++j) { const f32x4 gp = *(const f32x4*)(gpre + 4 * lane + 256 * j), s1 = *(const f32x4*)(md + sc_off + 4 * lane + 256 * j), s0 = *(const f32x4*)(md + sh_off + 4 * lane + 256 * j);
                const f32x4 h = (v[r][j] * rr * gp) * (s1 + 1.0f) + s0;
                u32x2 w; w.x = pk2(h[0], h[1]); w.y = pk2(h[2], h[3]); *(u32x2*)(XN + ro + 256 * j) = w; }
        }
    }
}

#define XB_TMO      128
#define XB_XCNT(j)  (256  + 64 * (j))
#define XB_XSUB(j)  (1280 + 64 * (j))
#define XB_XGEN(j)  (2304 + 64 * (j))
#define XB_TOP      3328
#define XB_TOPGEN   3392
#define XCD_BAR_WORDS 3456
#define XB_SPIN_CAP (1u << 20)
__device__ __forceinline__ unsigned xb_ld(unsigned* p)              { return __hip_atomic_load(p, __ATOMIC_RELAXED, __HIP_MEMORY_SCOPE_AGENT); }
__device__ __forceinline__ unsigned xb_add(unsigned* p, unsigned v) { return __hip_atomic_fetch_add(p, v, __ATOMIC_RELAXED, __HIP_MEMORY_SCOPE_AGENT); }
__device__ __forceinline__ unsigned xb_xcc_id() { return (unsigned)__builtin_amdgcn_s_getreg((3 << 11) | 20) & 0xFu; }
#define XB_SPIN(cond, bar) do { unsigned _sp = 0; while (cond) { __builtin_amdgcn_s_sleep(1); \
    if ((++_sp & 255u) == 0u) { if (xb_ld(&(bar)[XB_TMO])) break; if (_sp > XB_SPIN_CAP) { atomicAdd(&(bar)[XB_TMO], 1u); break; } } } } while (0)
struct XcdBarrier { unsigned* bar; unsigned x; volatile LAS unsigned* st; };
__device__ __forceinline__ XcdBarrier xcd_barrier_post(unsigned* bar, volatile LAS unsigned* st, int wave_s) {
    XcdBarrier b; b.bar = bar; b.x = xb_xcc_id(); b.st = st;
    if (flat_tid(wave_s) == 0) (void)xb_add(&bar[XB_XCNT(b.x)], 1u);
    return b;
}
__device__ __forceinline__ void xcd_barrier_complete(unsigned* bar, unsigned x, unsigned& nloc, unsigned& nx) {
    const unsigned G = gridDim.x * gridDim.y * gridDim.z;
    unsigned sum, cnt, mine, sp = 0u;
    for (;;) {
        sum = 0u; cnt = 0u; mine = 0u;
#pragma unroll
        for (unsigned j = 0; j < 16; ++j) { const unsigned c = xb_ld(&bar[XB_XCNT(j)]); sum += c; cnt += (c > 0u) ? 1u : 0u; mine = (j == x) ? c : mine; }
        if (sum == G) break;
        __builtin_amdgcn_s_sleep(1);
        if ((++sp & 255u) == 0u) { if (xb_ld(&bar[XB_TMO])) break; if (sp > XB_SPIN_CAP) { atomicAdd(&bar[XB_TMO], 1u); break; } }
    }
    nloc = mine > 0u ? mine : 1u; nx = cnt > 0u ? cnt : 1u;
}
__device__ __forceinline__ void xcd_barrier(const XcdBarrier& b, int wave_s) {
    asm volatile("s_waitcnt vmcnt(0)" ::: "memory");
    __syncthreads();
    if (flat_tid(wave_s) == 0) {
        unsigned* bar = b.bar; unsigned bx = b.x;
        asm volatile("" : "+s"(bx));
        __builtin_amdgcn_s_waitcnt(0);
        unsigned nloc = b.st[0], nx = b.st[1];
        if (nloc == 0u) { xcd_barrier_complete(bar, bx, nloc, nx); b.st[0] = nloc; b.st[1] = nx; }
        const unsigned old = xb_add(&bar[XB_XSUB(bx)], 1u);
        const unsigned gen = old / nloc;
        if (old + 1u == (gen + 1u) * nloc) {
            __builtin_amdgcn_fence(__ATOMIC_RELEASE, "agent");
            asm volatile("s_waitcnt vmcnt(0)" ::: "memory");
            const unsigned og = xb_add(&bar[XB_TOP], 1u);
            const unsigned tg = og / nx;
            if (og + 1u == (tg + 1u) * nx) xb_add(&bar[XB_TOPGEN], 1u);
            else XB_SPIN(xb_ld(&bar[XB_TOPGEN]) == tg, bar);
            __builtin_amdgcn_fence(__ATOMIC_ACQUIRE, "agent");
            xb_add(&bar[XB_XGEN(bx)], 1u);
            asm volatile("s_waitcnt vmcnt(0)" ::: "memory");
        } else {
            XB_SPIN(xb_ld(&bar[XB_XGEN(bx)]) == gen, bar);
            __builtin_amdgcn_fence(__ATOMIC_ACQUIRE, "agent");
            asm volatile("s_waitcnt vmcnt(0)" ::: "memory");
        }
    }
    __syncthreads();
}

constexpr int LDS_BYTES = 148 * 1024;

__global__ void __launch_bounds__(NTHR, 2) fwd_megakernel(Params P) {
    extern __shared__ __attribute__((aligned(16))) unsigned char lds_raw[];
    LAS unsigned char* lds = (LAS unsigned char*)lds_raw;
    cg::grid_group grid = cg::this_grid();
    volatile LAS unsigned* MISC = (volatile LAS unsigned*)(lds + 3 * 128 * (S96 + S64) + 64);
    const int wave_s = __builtin_amdgcn_readfirstlane((int)threadIdx.x >> 6);
    const int tid0 = flat_tid(wave_s);
    if (tid0 < 32) MISC[tid0] = 0u;
    unsigned* barw = (unsigned*)(P.ws + WS_BAR);
    if (blockIdx.x == 0) for (int i = tid0; i < XCD_BAR_WORDS; i += NTHR) __hip_atomic_store(barw + i, 0u, __ATOMIC_RELAXED, __HIP_MEMORY_SCOPE_AGENT);
    { unsigned* xc = (unsigned*)(P.ws + WS_XCNT); for (int i = blockIdx.x * NTHR + tid0; i < 16 * 256 * 64; i += gridDim.x * NTHR) __hip_atomic_store(xc + i, 0u, __ATOMIC_RELAXED, __HIP_MEMORY_SCOPE_AGENT); }
    asm volatile("s_waitcnt vmcnt(0)" ::: "memory");
    __syncthreads();
    grid.sync();
    __builtin_amdgcn_fence(__ATOMIC_ACQUIRE, "agent");
    asm volatile("s_waitcnt vmcnt(0)" ::: "memory");
    const XcdBarrier xbar = xcd_barrier_post(barw, MISC + 8, wave_s);
#define GSYNC() xcd_barrier(xbar, wave_s)
    const int G = gridDim.x, bid = blockIdx.x, NGW = G * NWAVE;
#define LOCAL_IDS int tid = flat_tid(wave_s); asm volatile("" : "+v"(tid)); const int lane = tid & 63, wave = __builtin_amdgcn_readfirstlane(tid >> 6), gw = bid * NWAVE + wave; (void)lane; (void)gw;
    unsigned char* ws = P.ws;
    float* modp = (float*)(ws + WS_MOD);
    float* cosT = (float*)(ws + WS_ROPE); float* sinT = cosT + SEQ * 16;
    float* rq = (float*)(ws + WS_RQ); float* rkv = rq + MTOK;
    float* lutg = (float*)(ws + WS_LUT);
    float* lse = (float*)(ws + WS_LSE);
    bf16_t* XN = (bf16_t*)(ws + WS_XN);
    bf16_t* Z = (bf16_t*)(ws + WS_Z);
    bf16_t* QB = (bf16_t*)(ws + WS_Q);
    bf16_t* KVB = (bf16_t*)(ws + WS_KV);
    bf16_t* PART = (bf16_t*)(ws + WS_PART);
    bf16_t* OB = XN;
    bf16_t* YMIX = Z;
    bf16_t* GB = (bf16_t*)(ws + WS_G);
    bf16_t* HID = (bf16_t*)(ws + WS_HID);
    bf16_t* YFFN = XN;

    {
        LOCAL_IDS
        LAS float* scr = (LAS float*)(lds + wave * 16384);
        constexpr int IT_IN = 16 * 93, IT_OUT = 16 * 32, IT_UP = 16 * 176, IT_DOWN = 44 * 32, IT_UQ = 6 * 12, IT_UKV = 4 * 16;
        constexpr int IT_L = IT_IN + IT_OUT + IT_UP + IT_DOWN + IT_UQ + IT_UKV;
        for (int it = gw; it < DEPTH * IT_L; it += NGW) {
            const int l = it / IT_L; int r = it % IT_L;
            unsigned char* wl = ws + WS_W + (size_t)l * WL_STRIDE;
            if (r < IT_IN) { transpose_item(P.in[I_WIN] + (size_t)l * DM * DIN, DM, DIN, (bf16_t*)(wl + WL_IN), nullptr, scr, r, lane); continue; } r -= IT_IN;
            if (r < IT_OUT) { transpose_item(P.in[I_WOUT] + (size_t)l * DM * DM, DM, DM, (bf16_t*)(wl + WL_OUT), nullptr, scr, r, lane); continue; } r -= IT_OUT;
            if (r < IT_UP) { transpose_item(P.in[I_WUP] + (size_t)l * DM * 2 * DFF, DM, 2 * DFF, (bf16_t*)(wl + WL_UP), nullptr, scr, r, lane); continue; } r -= IT_UP;
            if (r < IT_DOWN) { transpose_item(P.in[I_WDOWN] + (size_t)l * DFF * DM, DFF, DM, (bf16_t*)(wl + WL_DOWN), nullptr, scr, r, lane); continue; } r -= IT_DOWN;
            if (r < IT_UQ) { transpose_item(P.in[I_WUQ] + (size_t)l * 384 * 384, 384, 384, (bf16_t*)(wl + WL_UQ), P.in[I_GQ] + l * 384, scr, r, lane); continue; } r -= IT_UQ;
            transpose_item(P.in[I_WUKV] + (size_t)l * 256 * 512, 256, 512, (bf16_t*)(wl + WL_UKV), P.in[I_GKV] + l * 256, scr, r, lane);
        }
        {
            constexpr int PZ_IN = 96 * 1024 / 8, PZ_UQ = 128 * 384 / 8, PZ_L = PZ_IN + PZ_UQ;
            const u32x4 z4 = {0u, 0u, 0u, 0u};
            for (int it = bid * NTHR + tid; it < DEPTH * PZ_L; it += G * NTHR) {
                const int l = it / PZ_L, r = it % PZ_L;
                unsigned char* wl = ws + WS_W + (size_t)l * WL_STRIDE;
                if (r < PZ_IN) *(u32x4*)(wl + WL_IN + (size_t)DIN * DM * 2 + (size_t)r * 16) = z4;
                else *(u32x4*)(wl + WL_UQ + (size_t)384 * 384 * 2 + (size_t)(r - PZ_IN) * 16) = z4;
            }
        }
        for (int it = bid * NTHR + tid; it < SEQ * 16; it += G * NTHR) {
            const int s = it >> 4, i = it & 15;
            const float invf = powf(10000.0f, -(float)(2 * i) / 32.0f);
            const float ang = (float)s * invf;
            const double t = (double)ang * 0.15915494309189535;
            const float fr = (float)(t - floor(t));
            cosT[it] = __builtin_amdgcn_cosf(fr); sinT[it] = __builtin_amdgcn_sinf(fr);
        }
        for (int it = bid * NTHR + tid; it < 3 * 8 * 129; it += G * NTHR) {
            const int p = it / (8 * 129), h = (it / 129) % 8, idx = it % 129, rel = idx - 64, n = rel < 0 ? -rel : rel;
            const int bk = (int)T5B[p][n] + (rel > 0 ? 16 : 0);
            lutg[(p * 8 + h) * 132 + idx] = P.in[I_T5][bk * 8 + h] * LOG2E;
        }
        __syncthreads();
        for (int pair = bid; pair < 96; pair += G) {
            const int l = pair / 24, nc = pair % 24, ks = wave;
#pragma unroll 4
            for (int e = lane; e < 2048; e += 64) { const int b = e >> 7, k = e & 127; const float cv = P.in[I_C][b * DM + ks * 128 + k]; scr[e] = cv / (1.0f + __expf(-cv)); }
            asm volatile("s_waitcnt lgkmcnt(0)" ::: "memory");
            f32x4 accm[16];
#pragma unroll
            for (int b = 0; b < 16; ++b) accm[b] = (f32x4){0.f, 0.f, 0.f, 0.f};
            const float* wp = P.in[I_WADA] + ((size_t)l * DM + ks * 128) * 6144 + nc * 256 + 4 * lane;
#pragma unroll 4
            for (int k = 0; k < 128; ++k) {
                const f32x4 w = *(const f32x4*)(wp + (size_t)k * 6144);
#pragma unroll
                for (int b = 0; b < 16; ++b) accm[b] = accm[b] + w * scr[b * 128 + k];
            }
            asm volatile("s_waitcnt lgkmcnt(0)" ::: "memory");
#pragma unroll
            for (int b = 0; b < 16; ++b) *(LAS f32x4*)(scr + b * 256 + 4 * lane) = accm[b];
            __syncthreads();
            const LAS float* part = (const LAS float*)lds;
#pragma unroll
            for (int j = 0; j < 8; ++j) {
                const int o = tid + NTHR * j, b = o >> 8, n = o & 255;
                float sum = P.in[I_BADA][l * 6144 + nc * 256 + n];
#pragma unroll
                for (int w = 0; w < 8; ++w) sum += part[w * 4096 + o];
                modp[((size_t)l * 16 + b) * 6144 + nc * 256 + n] = sum;
            }
            __syncthreads();
        }
    }
    GSYNC();
    { LOCAL_IDS
    for (int row = gw; row < MTOK; row += 4 * NGW)
        rowwise_rows<4>(row, NGW, P.in[I_X], nullptr, nullptr, 0, modp, nullptr, P.in[I_GPREMIX], 1024, 0, XN, lane);
    }
    GSYNC();

    for (int l = 0; l < DEPTH; ++l) {
        unsigned char* wl = ws + WS_W + (size_t)l * WL_STRIDE;
        const float* modl = modp + (size_t)l * 16 * 6144;
        {
            pg8::Gemm g{XN, (const bf16_t*)(wl + WL_IN), MTOK, ZLD, DM, DM}; pg8::StaticOrder S; S.init(MTOK, ZLD, G, bid);
            pg8::EpiStore E{Z, ZLD, ZLD, 1, cosT, sinT};
            pg8::gemm_phase(lds, g, S, E, wave_s);
        }
        GSYNC();
        {
            pg8::Gemm g{Z + ZC_CQ, (const bf16_t*)(wl + WL_UQ), MTOK, 512, 384, ZLD}; pg8::StaticOrder S; S.init(MTOK, 512, G, bid);
            pg8::EpiStore E{QB, 384, 384, 2, cosT, sinT};
            pg8::gemm_phase(lds, g, S, E, wave_s);
        }
        {
            pg8::Gemm g{Z + ZC_CKV, (const bf16_t*)(wl + WL_UKV), MTOK, 512, 256, ZLD}; pg8::StaticOrder S; S.init(MTOK, 512, G, bid);
            pg8::EpiStore16 E{KVB, 512};
            pg8::gemm_phase(lds, g, S, E, wave_s);
        }
        { LOCAL_IDS
        for (int row0 = gw; row0 < MTOK; row0 += 4 * NGW) {
            u32x4 v0[4], v1[4];
#pragma unroll
            for (int r = 0; r < 4; ++r) { const bf16_t* zr = Z + (size_t)(row0 + r * NGW) * ZLD + ZC_CQ; v0[r] = *(const u32x4*)(zr + 8 * lane);
                v1[r] = (u32x4){0u, 0u, 0u, 0u}; if (lane < 16) v1[r] = *(const u32x4*)(zr + 8 * (lane + 64)); }
#pragma unroll
            for (int r = 0; r < 4; ++r) {
                const u32x4 a = v0[r], c = v1[r];
                const float s0 = bflo(a.x) * bflo(a.x) + bfhi(a.x) * bfhi(a.x) + bflo(a.y) * bflo(a.y) + bfhi(a.y) * bfhi(a.y) + bflo(a.z) * bflo(a.z) + bfhi(a.z) * bfhi(a.z) + bflo(a.w) * bflo(a.w) + bfhi(a.w) * bfhi(a.w);
                const float s1 = bflo(c.x) * bflo(c.x) + bfhi(c.x) * bfhi(c.x) + bflo(c.y) * bflo(c.y) + bfhi(c.y) * bfhi(c.y) + bflo(c.z) * bflo(c.z) + bfhi(c.z) * bfhi(c.z) + bflo(c.w) * bflo(c.w) + bfhi(c.w) * bfhi(c.w);
                float sq = lane < 48 ? s0 : 0.f, sk = (lane < 48 ? 0.f : s0) + s1;
                sq = wave_sum(sq); sk = wave_sum(sk);
                if (lane == 0) { const int row = row0 + r * NGW; rq[row] = rsqrtf(sq * (1.0f / 384.0f) + EPS); rkv[row] = rsqrtf(sk * (1.0f / 256.0f) + EPS); }
            }
        } }
        {
            LOCAL_IDS
            LAS unsigned char* Kl = lds; LAS unsigned char* Vl = lds + 400 * S64; LAS float* biasL = (LAS float*)(lds + 2 * 400 * S64);
            const int i = lane & 15, g4 = lane >> 4, w16 = 16 * wave;
            const int per = (24 * 256 + G - 1) / G, u0 = bid * per, u1 = min(u0 + per, 24 * 256);
            u32x4 pk[6], pvv[6], pq[2][2];
            if (tid < S64) { const u32x4 z4 = {0u, 0u, 0u, 0u}; *(LAS u32x4*)(Kl + 384 * S64 + tid * 16) = z4; *(LAS u32x4*)(Vl + 384 * S64 + tid * 16) = z4; }
            auto decode = [&](int unit, int& p, int& h, int& b, int& r, int& mb, int& dl) {
                const int ph = unit >> 8, rest = unit & 255; p = ph >> 3; h = ph & 7; b = rest >> 4; const int rm = rest & 15;
                dl = 2 * p; const int nmb = 16 >> dl; r = rm / nmb; mb = rm % nmb; };
            auto issue = [&](int unit) {
                int p, h, b, r, mb, dl; decode(unit, p, h, b, r, mb, dl);
                const int L = SEQ >> dl;
                const bf16_t* zb = Z + (size_t)b * SEQ * ZLD + 64 * h;
#pragma unroll
                for (int it = 0; it < 6; ++it) {
                    const int c = tid + NTHR * it, row = c >> 3, ch = c & 7, mk = 256 * mb - 64 + row;
                    pk[it] = (u32x4){0u, 0u, 0u, 0u}; pvv[it] = (u32x4){0u, 0u, 0u, 0u};
                    if (mk >= 0 && mk < L) { const bf16_t* src = zb + (size_t)((mk << dl) + r) * ZLD + 8 * ch; pk[it] = *(const u32x4*)(src + ZC_KB); pvv[it] = *(const u32x4*)(src + ZC_VB); }
                }
#pragma unroll
                for (int t = 0; t < 2; ++t) { const int tq = ((256 * mb + 128 * t + w16 + i) << dl) + r;
                    const bf16_t* qp = zb + (size_t)tq * ZLD + ZC_QB + 8 * g4; pq[t][0] = *(const u32x4*)qp; pq[t][1] = *(const u32x4*)(qp + 32); }
            };
            auto commit = [&]() {
#pragma unroll
                for (int it = 0; it < 6; ++it) { const int c = tid + NTHR * it, row = c >> 3, ch = c & 7;
                    *(LAS u32x4*)(Kl + row * S64 + ch * 16) = pk[it]; *(LAS u32x4*)(Vl + row * S64 + ch * 16) = pvv[it]; }
            };
            int cur_ph = -1;
            issue(min(u0, 24 * 256 - 1));
            for (int unit = u0; unit < u1; ++unit) {
                int p, h, b, r, mb, dl; decode(unit, p, h, b, r, mb, dl);
                const int L = SEQ >> dl, nmb = 16 >> dl;
                commit();
                if ((unit >> 8) != cur_ph) {
                    cur_ph = unit >> 8;
                    const float* lg = lutg + cur_ph * 132;
                    for (int e = tid; e < 2560; e += NTHR) { const int st = e >> 9, ln = (e >> 3) & 63, jj = e & 7;
                        const int rel = 32 * st + 4 * (ln >> 4) + (jj & 3) + 16 * (jj >> 2) - 64 - (ln & 15); const bool ok = (rel >= -64) && (rel <= 64);
                        biasL[e] = ok ? lg[min(max(rel + 64, 0), 128)] : -INFINITY; }
                }
                bf16x8 qf[2][1][2]; f32x4 o[2][1][4]; float mr[2][1], lr[2][1];
#pragma unroll
                for (int t = 0; t < 2; ++t) {
                    qf[t][0][0] = __builtin_bit_cast(bf16x8, scale_bf8(pq[t][0], 0.125f * LOG2E)); qf[t][0][1] = __builtin_bit_cast(bf16x8, scale_bf8(pq[t][1], 0.125f * LOG2E));
                    mr[t][0] = 0.f; lr[t][0] = 0.f;
#pragma unroll
                    for (int db = 0; db < 4; ++db) o[t][0][db] = (f32x4){0.f, 0.f, 0.f, 0.f};
                }
                __syncthreads();
                if (unit + 1 < u1) issue(unit + 1);
                const bool edge = (mb == 0) || (mb == nmb - 1);
#pragma unroll 1
                for (int st = 0; st < 5; ++st) {
                    auto bm = [&](f32x4& s0, f32x4& s1, int kb, int) {
                        const LAS f32x4* bp = (const LAS f32x4*)(biasL + (st * 64 + lane) * 8);
                        s0 = s0 + bp[0]; s1 = s1 + bp[1];
                        if (edge) {
#pragma unroll
                            for (int j = 0; j < 4; ++j) { const int mk0 = 256 * mb - 64 + kb + 4 * g4 + j, mk1 = mk0 + 16;
                                if (mk0 < 0 || mk0 >= L) s0[j] = -INFINITY; if (mk1 < 0 || mk1 >= L) s1[j] = -INFINITY; }
                        }
                    };
#pragma unroll
                    for (int t = 0; t < 2; ++t) attn_step<2, 1, S64>(Kl, Vl, 128 * t + w16 + 32 * st, qf[t], o[t], mr[t], lr[t], lane, bm);
                }
#pragma unroll
                for (int t = 0; t < 2; ++t) {
                    const int tq = ((256 * mb + 128 * t + w16 + i) << dl) + r;
                    float lt = lr[t][0]; lt += __shfl_xor(lt, 16); lt += __shfl_xor(lt, 32);
                    const float inv = 1.0f / lt;
                    bf16_t* op = PART + ((size_t)p * MTOK + (size_t)b * SEQ + tq) * 512 + 64 * h + 4 * g4;
#pragma unroll
                    for (int db = 0; db < 4; ++db) { u32x2 w; w.x = pk2(o[t][0][db][0] * inv, o[t][0][db][1] * inv); w.y = pk2(o[t][0][db][2] * inv, o[t][0][db][3] * inv); *(u32x2*)(op + 16 * db) = w; }
                    if (g4 == 0) lse[((size_t)p * MTOK + (size_t)b * SEQ + tq) * 8 + h] = mr[t][0] + __log2f(lt);
                }
                __syncthreads();
            }
        }
        GSYNC();
        {
            LOCAL_IDS
            constexpr int KB_BYTES = 128 * S96, BUF_BYTES = 128 * S96 + 128 * S64;
            const int i = lane & 15, g4 = lane >> 4;
            const float qscale = 0.10206207261596575f * LOG2E;
            for (int unit = bid; unit < 1024; unit += G) {
                const int b = unit >> 6, h = (unit >> 4) & 3, qb = unit & 15;
                const size_t tb = (size_t)b * SEQ;
                bf16x8 qf[2][3];
#pragma unroll
                for (int t = 0; t < 2; ++t) { const size_t row = tb + qb * 256 + 32 * wave + 16 * t + i; const float sc = rq[row] * qscale;
                    const bf16_t* qp = QB + row * 384 + 96 * h + 8 * g4;
#pragma unroll
                    for (int ks = 0; ks < 3; ++ks) qf[t][ks] = load_q(qp + 32 * ks, sc); }
                f32x4 o[2][4];
#pragma unroll
                for (int t = 0; t < 2; ++t)
#pragma unroll
                    for (int db = 0; db < 4; ++db) o[t][db] = (f32x4){0.f, 0.f, 0.f, 0.f};
                u32x4 pre[5]; unsigned prs;
                auto issue = [&](int c) {
                    int t2 = tid; asm volatile("" : "+v"(t2));
                    const unsigned offKV = (unsigned)(t2 >> 3) * 1024u + (unsigned)(t2 & 7) * 16u, offZ = (unsigned)(t2 >> 2) * (unsigned)(ZLD * 2) + (unsigned)(t2 & 3) * 16u;
                    const size_t key0 = tb + (size_t)c * 128;
                    const char* kvb = (const char*)(KVB + key0 * 512 + 128 * h);
                    pre[0] = *(const u32x4*)(kvb + offKV); pre[1] = *(const u32x4*)(kvb + 65536 + offKV);
                    pre[2] = *(const u32x4*)(kvb + 128 + offKV); pre[3] = *(const u32x4*)(kvb + 128 + 65536 + offKV);
                    pre[4] = *(const u32x4*)((const char*)(Z + key0 * ZLD + ZC_KR) + offZ);
                    prs = pk2(rkv[key0 + (t2 >> 3)], rkv[key0 + 64 + (t2 >> 3)]);
                };
                auto commit = [&](int buf) {
                    int t2 = tid; asm volatile("" : "+v"(t2));
                    const int ldsK = (t2 >> 3) * S96 + (t2 & 7) * 16, ldsV = KB_BYTES + (t2 >> 3) * S64 + (t2 & 7) * 16, ldsR = (t2 >> 2) * S96 + 128 + (t2 & 3) * 16;
                    LAS unsigned char* base = lds + buf * BUF_BYTES;
                    *(LAS u32x4*)(base + ldsK) = scale_bf8(pre[0], bflo(prs)); *(LAS u32x4*)(base + ldsK + 64 * S96) = scale_bf8(pre[1], bfhi(prs));
                    *(LAS u32x4*)(base + ldsV) = scale_bf8(pre[2], bflo(prs)); *(LAS u32x4*)(base + ldsV + 64 * S64) = scale_bf8(pre[3], bfhi(prs));
                    *(LAS u32x4*)(base + ldsR) = pre[4];
                };
                constexpr float THR = 8.0f;
                bf16x8 kf[6]; f32x4 s0[2], s1[2], negm[2], lacc[2];
                const bf16x8 ones = {0x3f80, 0x3f80, 0x3f80, 0x3f80, 0x3f80, 0x3f80, 0x3f80, 0x3f80};
#pragma unroll
                for (int t = 0; t < 2; ++t) { negm[t] = (f32x4){0.f, 0.f, 0.f, 0.f}; lacc[t] = (f32x4){0.f, 0.f, 0.f, 0.f}; }
                auto kload = [&](LAS const unsigned char* Kl, int kb) {
                    LAS const unsigned char* kp = Kl + (kb + i) * S96 + g4 * 16;
#pragma unroll
                    for (int ks = 0; ks < 3; ++ks) { kf[2 * ks] = *(LAS const bf16x8*)(kp + ks * 64); kf[2 * ks + 1] = *(LAS const bf16x8*)(kp + 16 * S96 + ks * 64); }
                };
                auto qkm = [&]() {
#pragma unroll
                    for (int t = 0; t < 2; ++t) {
                        s0[t] = __builtin_amdgcn_mfma_f32_16x16x32_bf16(kf[0], qf[t][0], negm[t], 0, 0, 0);
                        s1[t] = __builtin_amdgcn_mfma_f32_16x16x32_bf16(kf[1], qf[t][0], negm[t], 0, 0, 0);
                    }
#pragma unroll
                    for (int ks = 1; ks < 3; ++ks)
#pragma unroll
                        for (int t = 0; t < 2; ++t) {
                            s0[t] = __builtin_amdgcn_mfma_f32_16x16x32_bf16(kf[2 * ks], qf[t][ks], s0[t], 0, 0, 0);
                            s1[t] = __builtin_amdgcn_mfma_f32_16x16x32_bf16(kf[2 * ks + 1], qf[t][ks], s1[t], 0, 0, 0);
                        }
                };
                auto smpv = [&](LAS const unsigned char* vp) {
                    bf16x8 pb[2];
#pragma unroll
                    for (int t = 0; t < 2; ++t) {
                        float mx = __builtin_fmaxf(__builtin_fmaxf(s0[t][0], s0[t][1]), s0[t][2]);
                        mx = __builtin_fmaxf(__builtin_fmaxf(mx, s0[t][3]), s1[t][0]);
                        mx = __builtin_fmaxf(__builtin_fmaxf(mx, s1[t][1]), s1[t][2]);
                        mx = __builtin_fmaxf(mx, s1[t][3]);
                        if (__any(mx > THR)) {
                            mx = fmaxf(mx, __shfl_xor(mx, 16)); mx = fmaxf(mx, __shfl_xor(mx, 32));
                            const float dl = fmaxf(mx, 0.f);
                            const float alpha = __builtin_amdgcn_exp2f(-dl);
                            negm[t] = negm[t] - dl;
                            lacc[t] = lacc[t] * alpha;
#pragma unroll
                            for (int db = 0; db < 4; ++db) o[t][db] = o[t][db] * alpha;
                            s0[t] = s0[t] - dl; s1[t] = s1[t] - dl;
                        }
                        u32x4 w;
                        w.x = pk2(__builtin_amdgcn_exp2f(s0[t][0]), __builtin_amdgcn_exp2f(s0[t][1])); w.y = pk2(__builtin_amdgcn_exp2f(s0[t][2]), __builtin_amdgcn_exp2f(s0[t][3]));
                        w.z = pk2(__builtin_amdgcn_exp2f(s1[t][0]), __builtin_amdgcn_exp2f(s1[t][1])); w.w = pk2(__builtin_amdgcn_exp2f(s1[t][2]), __builtin_amdgcn_exp2f(s1[t][3]));
                        pb[t] = __builtin_bit_cast(bf16x8, w);
                    }
#pragma unroll
                    for (int t = 0; t < 2; ++t) lacc[t] = __builtin_amdgcn_mfma_f32_16x16x32_bf16(ones, pb[t], lacc[t], 0, 0, 0);
#pragma unroll
                    for (int db = 0; db < 4; ++db) {
                        const s16x4 lo = vtr(vp + db * 32), hi = vtr(vp + 16 * S64 + db * 32);
                        const bf16x8 va = {lo[0], lo[1], lo[2], lo[3], hi[0], hi[1], hi[2], hi[3]};
#pragma unroll
                        for (int t = 0; t < 2; ++t) o[t][db] = __builtin_amdgcn_mfma_f32_16x16x32_bf16(va, pb[t], o[t][db], 0, 0, 0);
                    }
                };
#define MLA_VP(VL, KBV) ((VL) + ((KBV) + 4 * g4 + (i >> 2)) * S64 + (i & 3) * 8)
#define MLA_STEP(KLN, KBN, VL, KBV) do { kload(KLN, KBN); __builtin_amdgcn_sched_barrier(0); smpv(MLA_VP(VL, KBV)); qkm(); __builtin_amdgcn_sched_barrier(0); } while (0)
                issue(0); commit(0); issue(1);
                __syncthreads();
                kload(lds, 0); qkm();
                int bc = 0;
                for (int c = 0; c < 32; ++c) {
                    const int bn = (bc == 2) ? 0 : bc + 1;
                    if (c + 1 < 32) commit(bn);
                    if (c + 2 < 32) issue(c + 2);
                    LAS const unsigned char* Kl = lds + bc * BUF_BYTES; LAS const unsigned char* Vl = Kl + KB_BYTES;
                    MLA_STEP(Kl, 32, Vl, 0);
                    MLA_STEP(Kl, 64, Vl, 32);
                    MLA_STEP(Kl, 96, Vl, 64);
                    __syncthreads();
                    if (c + 1 < 32) { MLA_STEP(lds + bn * BUF_BYTES, 0, Vl, 96); }
                    else { smpv(MLA_VP(Vl, 96)); }
                    bc = bn;
                }
#undef MLA_STEP
#undef MLA_VP
                __syncthreads();
#pragma unroll
                for (int t = 0; t < 2; ++t) {
                    const float inv = 1.0f / lacc[t][0];
                    bf16_t* op = OB + (tb + qb * 256 + 32 * wave + 16 * t + i) * DM + 768 + 64 * h + 4 * g4;
#pragma unroll
                    for (int db = 0; db < 4; ++db) { u32x2 w; w.x = pk2(o[t][db][0] * inv, o[t][db][1] * inv); w.y = pk2(o[t][db][2] * inv, o[t][db][3] * inv); *(u32x2*)(op + 16 * db) = w; }
                }
            }
        }
        {
            LOCAL_IDS
            LAS unsigned char* Kl = lds; LAS unsigned char* Vl = lds + 2 * 128 * S64; LAS float* lutl = (LAS float*)(lds + 4 * 128 * S64);
            const int i = lane & 15, g4 = lane >> 4, hh = wave >> 2, ct = wave & 3;
            const int cbase = ct == 0 ? 0 : (ct == 1 ? 8 : (ct == 2 ? 24 : 32));
            const float* rpb = P.in[I_RPB] + (size_t)l * 4 * 465;
            for (int e = tid; e < 1860; e += NTHR) lutl[e] = rpb[e] * LOG2E;
            int bid2 = bid; asm volatile("" : "+s"(bid2));
            const int per = (2048 + G - 1) / G, u0 = min(bid2 * per, 2047), u1 = min(bid2 * per + per, 2048), nf = (u1 - u0) * 4;
            const int qc = 16 * ct + i, cs = min(max(qc - 8, 0), 48);
            u32x4 pk[4], pvv[4], pq[2];
            auto issue = [&](int f) {
                const int unit = u0 + (f >> 2), c = f & 3, b = unit >> 7, rr = (unit >> 1) & 63, hp = unit & 1;
                const int r0 = min(max(rr - 4, 0), 56), tk0 = (r0 + 2 * c) * 64;
                const bf16_t* zb = Z + (size_t)b * SEQ * ZLD;
#pragma unroll
                for (int it = 0; it < 4; ++it) {
                    const int e = tid + NTHR * it, h2 = e >> 10, row = (e >> 3) & 127, ch = e & 7;
                    const bf16_t* src = zb + (size_t)(tk0 + row) * ZLD + 64 * (2 * hp + h2) + 8 * ch;
                    pk[it] = *(const u32x4*)(src + ZC_KA); pvv[it] = *(const u32x4*)(src + ZC_VA);
                }
                if (c == 0) { const bf16_t* qp = zb + (size_t)(rr * 64 + qc) * ZLD + ZC_QA + 64 * (2 * hp + hh) + 8 * g4; pq[0] = *(const u32x4*)qp; pq[1] = *(const u32x4*)(qp + 32); }
            };
            auto commit = [&]() {
#pragma unroll
                for (int it = 0; it < 4; ++it) { const int e = tid + NTHR * it, h2 = e >> 10, row = (e >> 3) & 127, ch = e & 7;
                    *(LAS u32x4*)(Kl + (h2 * 128 + row) * S64 + ch * 16) = pk[it]; *(LAS u32x4*)(Vl + (h2 * 128 + row) * S64 + ch * 16) = pvv[it]; }
            };
            bf16x8 qf[1][2]; f32x4 o[1][4]; float mr[1] = {0.f}, lr[1] = {0.f};
            qf[0][0] = (bf16x8){0, 0, 0, 0, 0, 0, 0, 0}; qf[0][1] = qf[0][0];
#pragma unroll
            for (int db = 0; db < 4; ++db) o[0][db] = (f32x4){0.f, 0.f, 0.f, 0.f};
            issue(0);
            for (int f = 0; f < nf; ++f) {
                const int unit = u0 + (f >> 2), c = f & 3, b = unit >> 7, rr = (unit >> 1) & 63, hp = unit & 1, head = 2 * hp + hh;
                const int r0 = min(max(rr - 4, 0), 56);
                commit();
                if (c == 0) {
                    qf[0][0] = __builtin_bit_cast(bf16x8, scale_bf8(pq[0], 0.125f * LOG2E)); qf[0][1] = __builtin_bit_cast(bf16x8, scale_bf8(pq[1], 0.125f * LOG2E));
                    mr[0] = 0.f; lr[0] = 0.f;
#pragma unroll
                    for (int db = 0; db < 4; ++db) o[0][db] = (f32x4){0.f, 0.f, 0.f, 0.f};
                }
                __syncthreads();
                if (f + 1 < nf) issue(f + 1);
#pragma unroll
                for (int kr = 0; kr < 2; ++kr) {
                    const int dr = (r0 + 2 * c + kr) - rr + 7;
                    const LAS float* lrow = lutl + head * 465 + dr * 31;
                    auto bm = [&](f32x4& s0, f32x4& s1, int, int) {
#pragma unroll
                        for (int j = 0; j < 4; ++j) {
                            { const int kc = cbase + 4 * g4 + j; const bool ok = (kc >= cs) && (kc < cs + 16); const int idx = min(max(kc - qc + 15, 0), 30);
                              s0[j] = ok ? s0[j] + lrow[idx] : -INFINITY; }
                            { const int kc = cbase + 16 + 4 * g4 + j; const bool ok = (kc >= cs) && (kc < cs + 16); const int idx = min(max(kc - qc + 15, 0), 30);
                              s1[j] = ok ? s1[j] + lrow[idx] : -INFINITY; }
                        }
                    };
                    attn_step<2, 1, S64>(Kl + hh * 128 * S64, Vl + hh * 128 * S64, kr * 64 + cbase, qf, o, mr, lr, lane, bm);
                }
                if (c == 3) {
                    float lt = lr[0]; lt += __shfl_xor(lt, 16); lt += __shfl_xor(lt, 32);
                    const float inv = 1.0f / lt;
                    bf16_t* op = OB + ((size_t)b * SEQ + rr * 64 + qc) * DM + 64 * head + 4 * g4;
#pragma unroll
                    for (int db = 0; db < 4; ++db) { u32x2 w; w.x = pk2(o[0][db][0] * inv, o[0][db][1] * inv); w.y = pk2(o[0][db][2] * inv, o[0][db][3] * inv); *(u32x2*)(op + 16 * db) = w; }
                }
                __syncthreads();
            }
        }
        { LOCAL_IDS
        const int h = lane >> 3;
        for (int row0 = gw; row0 < MTOK; row0 += 4 * NGW) {
            u32x4 pa[4], pb_[4], pc[4]; float l0[4], l1[4], l2[4];
#pragma unroll
            for (int r = 0; r < 4; ++r) { const size_t row = (size_t)(row0 + r * NGW);
                l0[r] = lse[((size_t)0 * MTOK + row) * 8 + h]; l1[r] = lse[((size_t)1 * MTOK + row) * 8 + h]; l2[r] = lse[((size_t)2 * MTOK + row) * 8 + h];
                pa[r] = *(const u32x4*)(PART + ((size_t)0 * MTOK + row) * 512 + 8 * lane);
                pb_[r] = *(const u32x4*)(PART + ((size_t)1 * MTOK + row) * 512 + 8 * lane);
                pc[r] = *(const u32x4*)(PART + ((size_t)2 * MTOK + row) * 512 + 8 * lane); }
#pragma unroll
            for (int r = 0; r < 4; ++r) {
                const float mx = fmaxf(l0[r], fmaxf(l1[r], l2[r]));
                float w0 = __builtin_amdgcn_exp2f(l0[r] - mx), w1 = __builtin_amdgcn_exp2f(l1[r] - mx), w2 = __builtin_amdgcn_exp2f(l2[r] - mx);
                const float inv = 1.0f / (w0 + w1 + w2); w0 *= inv; w1 *= inv; w2 *= inv;
                const u32x4 a = pa[r], bq = pb_[r], cq = pc[r];
                u32x4 o;
                o.x = pk2(w0 * bflo(a.x) + w1 * bflo(bq.x) + w2 * bflo(cq.x), w0 * bfhi(a.x) + w1 * bfhi(bq.x) + w2 * bfhi(cq.x));
                o.y = pk2(w0 * bflo(a.y) + w1 * bflo(bq.y) + w2 * bflo(cq.y), w0 * bfhi(a.y) + w1 * bfhi(bq.y) + w2 * bfhi(cq.y));
                o.z = pk2(w0 * bflo(a.z) + w1 * bflo(bq.z) + w2 * bflo(cq.z), w0 * bfhi(a.z) + w1 * bfhi(bq.z) + w2 * bfhi(cq.z));
                o.w = pk2(w0 * bflo(a.w) + w1 * bflo(bq.w) + w2 * bflo(cq.w), w0 * bfhi(a.w) + w1 * bfhi(bq.w) + w2 * bfhi(cq.w));
                *(u32x4*)(OB + (size_t)(row0 + r * NGW) * DM + 256 + 8 * lane) = o;
            }
        } }
        GSYNC();
        {
            pg8::Gemm g{OB, (const bf16_t*)(wl + WL_OUT), MTOK, DM, DM, DM}; pg8::StaticOrder S; S.init(MTOK, DM, G, bid);
            float* xs = (float*)(ws + WS_XSLOT); unsigned* xc = (unsigned*)(ws + WS_XCNT); const int q0 = (l * 2 + 0) * 2;
            pg8::EpiNorm E{(l == 0 ? P.in[I_X] : P.out), P.out, XN, P.in[I_GPOSTMIX] + l * DM, P.in[I_GPREFFN] + l * DM, modl, 2048, 4096, 3072,
                           xs + (size_t)q0 * MTOK * 4, xc + (size_t)q0 * 256 * 64, xs + (size_t)(q0 + 1) * MTOK * 4, xc + (size_t)(q0 + 1) * 256 * 64, lds + 131072};
            pg8::gemm_phase(lds, g, S, E, wave_s);
        }
        GSYNC();
        {
            pg8::Gemm g{XN, (const bf16_t*)(wl + WL_UP) + (size_t)DFF * DM, MTOK, DFF, DM, DM}; pg8::StaticOrder S; S.init(MTOK, DFF, G, bid);
            pg8::EpiStore16 E{GB, DFF};
            pg8::gemm_phase(lds, g, S, E, wave_s);
        }
        GSYNC();
        {
            pg8::Gemm g{XN, (const bf16_t*)(wl + WL_UP), MTOK, DFF, DM, DM}; pg8::StaticOrder S; S.init(MTOK, DFF, G, bid);
            pg8::EpiGate E{HID, GB, P.in[I_CONVW] + (size_t)l * 3 * DFF, P.in[I_CONVB] + (size_t)l * DFF};
            pg8::gemm_phase(lds, g, S, E, wave_s);
        }
        GSYNC();
        {
            pg8::Gemm g{HID, (const bf16_t*)(wl + WL_DOWN), MTOK, DM, DFF, DFF}; pg8::StaticOrder S; S.init(MTOK, DM, G, bid);
            float* xs = (float*)(ws + WS_XSLOT); unsigned* xc = (unsigned*)(ws + WS_XCNT); const int q0 = (l * 2 + 1) * 2;
            const int ln = (l + 1 < DEPTH) ? l + 1 : l;
            pg8::EpiNorm E{P.out, P.out, (l + 1 < DEPTH) ? XN : nullptr, P.in[I_GPOSTFFN] + l * DM, P.in[I_GPREMIX] + ln * DM, modl, 5120, (ln - l) * 16 * 6144 + 1024, (ln - l) * 16 * 6144,
                           xs + (size_t)q0 * MTOK * 4, xc + (size_t)q0 * 256 * 64, xs + (size_t)(q0 + 1) * MTOK * 4, xc + (size_t)(q0 + 1) * 256 * 64, lds + 131072};
            pg8::gemm_phase(lds, g, S, E, wave_s);
        }
        if (l + 1 < DEPTH) GSYNC();
    }
}

extern "C" void kernel_launch(void* const* d_in, const int* in_sizes, int n_in, void* d_out, int out_size, void* d_ws, size_t ws_size, hipStream_t stream) {
    static int grid_blocks = 0;
    if (grid_blocks == 0) {
        if (n_in != 20 || ws_size < WS_END) { fprintf(stderr, "kernel_launch: unexpected n_in %d or ws_size %zu\n", n_in, ws_size); grid_blocks = -1; return; }
        int dev = 0, cus = 0, per_cu = 0;
        hipGetDevice(&dev);
        hipDeviceGetAttribute(&cus, hipDeviceAttributeMultiprocessorCount, dev);
        if (hipFuncSetAttribute((const void*)fwd_megakernel, hipFuncAttributeMaxDynamicSharedMemorySize, LDS_BYTES) != hipSuccess) fprintf(stderr, "kernel_launch: hipFuncSetAttribute failed\n");
        hipOccupancyMaxActiveBlocksPerMultiprocessor(&per_cu, (const void*)fwd_megakernel, NTHR, LDS_BYTES);
        (void)hipGetLastError();
        if (per_cu < 1) { fprintf(stderr, "kernel_launch: occupancy query gives %d\n", per_cu); per_cu = 1; }
        grid_blocks = 256;
        if (cus < 256) fprintf(stderr, "kernel_launch: device has %d CUs, this kernel needs 256\n", cus);
    }
    if (grid_blocks < 0) return;
    Params p{};
    for (int i = 0; i < 20; ++i) p.in[i] = (const float*)d_in[i];
    p.out = (float*)d_out; p.ws = (unsigned char*)d_ws;
    void* args[] = {&p};
    hipError_t e = hipLaunchCooperativeKernel((const void*)fwd_megakernel, dim3(grid_blocks), dim3(NTHR), args, LDS_BYTES, stream);
    if (e != hipSuccess) fprintf(stderr, "cooperative launch failed: %s (grid %d)\n", hipGetErrorString(e), grid_blocks);
}
```

```cpp
#include <hip/hip_runtime.h>
#include <hip/hip_cooperative_groups.h>
#include <cstdint>
#include <cstdio>
namespace cg = cooperative_groups;

#define LAS __attribute__((address_space(3)))
typedef unsigned short bf16_t;
typedef short bf16x8 __attribute__((ext_vector_type(8)));
typedef short s16x4 __attribute__((ext_vector_type(4)));
typedef float f32x4 __attribute__((ext_vector_type(4)));
typedef float f32x2 __attribute__((ext_vector_type(2)));
typedef unsigned u32x4 __attribute__((ext_vector_type(4)));
typedef unsigned u32x2 __attribute__((ext_vector_type(2)));
typedef __bf16 bf16x2_t __attribute__((ext_vector_type(2)));

constexpr int DM = 1024, NB = 16, SEQ = 4096, MTOK = NB * SEQ, DEPTH = 4;
constexpr int DIN = 2976, ZLD = 3072, DFF = 2816;
constexpr int ZC_QA = 0, ZC_KA = 256, ZC_VA = 512, ZC_QB = 768, ZC_KB = 1280, ZC_VB = 1792, ZC_CQ = 2304, ZC_CKV = 2688, ZC_KR = 2944;
constexpr float EPS = 1e-6f, LOG2E = 1.4426950408889634f;
constexpr int NTHR = 512, NWAVE = 8;
constexpr int S64 = 160, S96 = 224;

constexpr size_t MiB = 1u << 20;
constexpr size_t WS_MOD = 0;
constexpr size_t WS_BAR = MiB + 768 * 1024;
constexpr size_t WS_ROPE = 2 * MiB;
constexpr size_t WS_RQ = 3 * MiB;
constexpr size_t WS_LUT = 3 * MiB + 512 * 1024;
constexpr size_t WS_LSE = 4 * MiB;
constexpr size_t WS_W = 16 * MiB;
constexpr size_t WL_STRIDE = 26 * MiB;
constexpr size_t WL_IN = 0, WL_OUT = 6 * MiB, WL_UP = 8 * MiB, WL_DOWN = 19 * MiB, WL_UQ = 24 * MiB + 512 * 1024, WL_UKV = 25 * MiB;
constexpr size_t WS_XN = 120 * MiB;
constexpr size_t WS_Z = 248 * MiB;
constexpr size_t WS_Q = 632 * MiB;
constexpr size_t WS_KV = 680 * MiB;
constexpr size_t WS_PART = 744 * MiB;
constexpr size_t WS_G = 248 * MiB;
constexpr size_t WS_HID = 600 * MiB;
constexpr size_t WS_XSLOT = 952 * MiB;
constexpr size_t WS_XCNT = 968 * MiB;
constexpr size_t WS_END = 969 * MiB;

__device__ __forceinline__ unsigned pk2(float lo, float hi) { f32x2 v = {lo, hi}; bf16x2_t b = __builtin_convertvector(v, bf16x2_t); return __builtin_bit_cast(unsigned, b); }
__device__ __forceinline__ float bflo(unsigned u) { return __uint_as_float(u << 16); }
__device__ __forceinline__ float bfhi(unsigned u) { return __uint_as_float(u & 0xffff0000u); }
__device__ __forceinline__ int flat_tid(int wave_s) { unsigned z = 0u; asm volatile("" : "+v"(z));
    return wave_s * 64 + (int)__builtin_amdgcn_mbcnt_hi(~0u, __builtin_amdgcn_mbcnt_lo(~0u, z)); }
__device__ __forceinline__ float wave_sum(float v) {
#pragma unroll
    for (int o = 1; o < 64; o <<= 1) v += __shfl_xor(v, o);
    return v;
}
__device__ __forceinline__ u32x4 scale_bf8(u32x4 v, float s) {
    u32x4 r;
    r.x = pk2(bflo(v.x) * s, bfhi(v.x) * s); r.y = pk2(bflo(v.y) * s, bfhi(v.y) * s);
    r.z = pk2(bflo(v.z) * s, bfhi(v.z) * s); r.w = pk2(bflo(v.w) * s, bfhi(v.w) * s);
    return r;
}

namespace pg8 {
constexpr int BM = 256, BK = 64, HALF = 128, HTB = HALF * BK * 2, STAGE_BYTES = 8 * HTB, NXCD = 8, WGM = 8;
__device__ __forceinline__ int lds_byte(int r, int c) { const int st = (r >> 4) * 2 + (c >> 5), rr = r & 15, cc = c & 31, ob = rr * 64 + cc * 2; return st * 1024 + (ob ^ (((ob >> 9) & 1) << 5)); }
__device__ __forceinline__ void stage_rc(int b, int& R, int& C) { const int st = b / 1024, sb = b % 1024, swz = sb ^ (((sb >> 9) & 1) << 5); R = (st >> 1) * 16 + swz / 64; C = (st & 1) * 32 + (swz % 64) / 2; }

__device__ __forceinline__ int perm32(int rho) { const int n = rho >> 4, i = rho & 15; return 8 * (i >> 2) + 4 * n + (i & 3); }
struct Unit { int pm, pn; };
struct Gemm { const bf16_t* A; const bf16_t* Bt; int M, N, K, lda; };

struct StaticOrder {
    int nM, nN, nwg, G, c;
    __device__ void init(int M, int N, int G_, int c_) { nM = M / BM; nN = N / BM; nwg = nM * nN; G = G_; c = c_; }
    __device__ bool next(int i, Unit& u) const {
        const long L = (long)i * G + c; if (L >= nwg) return false;
        int wgid = (int)L; { const int q = nwg / NXCD, r = nwg % NXCD, xcd = wgid % NXCD, off = wgid / NXCD; wgid = (xcd < r ? xcd * (q + 1) : r * (q + 1) + (xcd - r) * q) + off; }
        const int nig = WGM * nN, gid = wgid / nig, fm = gid * WGM, gsz = (nM - fm) < WGM ? (nM - fm) : WGM;
        u.pm = fm + ((wgid % nig) % gsz); u.pn = (wgid % nig) / gsz; return true;
    }
};

template <class Epi>
__device__ __forceinline__ void gemm_phase(LAS unsigned char* lds, const Gemm g, const StaticOrder& S, const Epi& E, int wave_s) {
    int tid = flat_tid(wave_s); asm volatile("" : "+v"(tid));
    const int wid = __builtin_amdgcn_readfirstlane(tid >> 6), lane = tid & 63, wr = wid >> 2, wc = wid & 3, fr = lane & 15, fq = lane >> 4;
    const int K = g.K, nt = K / BK, lda = g.lda;
    unsigned voffA[2], voffB[2];
#pragma unroll
    for (int i = 0; i < 2; ++i) { int R, C; stage_rc(tid * 16 + i * 8192, R, C);
        const int Rb = Epi::PERM ? ((R & ~31) + perm32(R & 31)) : R;
        voffA[i] = (unsigned)(R * lda + C) * 2u; voffB[i] = (unsigned)(Rb * K + C) * 2u; }
    const size_t kstep = (size_t)(BK * 2);
    const size_t hstepA = (size_t)HALF * lda * 2, hstepB = (size_t)HALF * K * 2;
    const size_t tstepA = 2 * hstepA, tstepB = 2 * hstepB;
    const unsigned ldsw = (unsigned)wid * 1024u;
    const int aoff = lds_byte(wr * 64 + fr, fq * 8), boff = lds_byte(wc * 32 + fr, fq * 8);
#define PG8_SA(b, h) (((b) * 2 + (h)) * HTB)
#define PG8_SB(b, h) ((4 + (b) * 2 + (h)) * HTB)
#define PG8_STAGE(bufoff, gbase, voff) do { _Pragma("unroll") for (int _i = 0; _i < 2; ++_i) \
        __builtin_amdgcn_global_load_lds((const unsigned*)((const char*)(gbase) + (voff)[_i]), (LAS unsigned*)(lds + (bufoff) + ldsw + _i * 8192), 16, 0, 0); } while (0)
#define PG8_LDA(dst, b, h) do { _Pragma("unroll") for (int m = 0; m < 4; ++m) _Pragma("unroll") for (int k = 0; k < 2; ++k) dst[m][k] = *(const LAS bf16x8*)(lds + PG8_SA(b, h) + aoff + m * 2048 + k * 1024); } while (0)
#define PG8_LDB(dst, b, h) do { _Pragma("unroll") for (int n = 0; n < 2; ++n) _Pragma("unroll") for (int k = 0; k < 2; ++k) dst[n][k] = *(const LAS bf16x8*)(lds + PG8_SB(b, h) + boff + n * 2048 + k * 1024); } while (0)
#define PG8_MMA(ai, bj, At, Bt) do { __builtin_amdgcn_s_setprio(1); _Pragma("unroll") for (int m = 0; m < 4; ++m) _Pragma("unroll") for (int n = 0; n < 2; ++n) _Pragma("unroll") for (int k = 0; k < 2; ++k) \
        acc[ai][bj][m][n] = __builtin_amdgcn_mfma_f32_16x16x32_bf16(Bt[n][k], At[m][k], acc[ai][bj][m][n], 0, 0, 0); __builtin_amdgcn_s_setprio(0); } while (0)
#define PG8_WAIT_V(n) asm volatile("s_waitcnt vmcnt(" #n ")" ::: "memory")
#define PG8_WAIT_L(n) asm volatile("s_waitcnt lgkmcnt(" #n ")" ::: "memory")
#define PG8_BAR __builtin_amdgcn_s_barrier()
#define PG8_SCHED __builtin_amdgcn_sched_barrier(0)
    Unit cur, nxt; int ui = 0;
    if (!S.next(0, cur)) return;
    f32x4 acc[2][2][4][2];
#pragma unroll
    for (int a = 0; a < 2; ++a)
#pragma unroll
        for (int b = 0; b < 2; ++b)
#pragma unroll
            for (int m = 0; m < 4; ++m)
#pragma unroll
                for (int n = 0; n < 2; ++n) acc[a][b][m][n] = (f32x4){0.f, 0.f, 0.f, 0.f};
    bf16x8 At[4][2], B0[2][2], B1[2][2];
    const char* cA = (const char*)g.A + (size_t)cur.pm * tstepA; const char* cB = (const char*)g.Bt + (size_t)cur.pn * tstepB;
    PG8_STAGE(PG8_SB(0, 0), cB, voffB); PG8_STAGE(PG8_SB(0, 1), cB + hstepB, voffB); PG8_STAGE(PG8_SA(0, 0), cA, voffA); PG8_STAGE(PG8_SA(0, 1), cA + hstepA, voffA);
    if (wr == 1) PG8_BAR;
    PG8_WAIT_V(2); PG8_BAR;
    PG8_STAGE(PG8_SB(1, 0), cB + kstep, voffB); PG8_STAGE(PG8_SA(1, 0), cA + kstep, voffA); PG8_STAGE(PG8_SB(1, 1), cB + hstepB + kstep, voffB);
    PG8_WAIT_V(6); PG8_BAR;
    for (;;) {
        const bool has_next = S.next(ui + 1, nxt);
        const char* nA = has_next ? (const char*)g.A + (size_t)nxt.pm * tstepA : cA; const char* nB = has_next ? (const char*)g.Bt + (size_t)nxt.pn * tstepB : cB;
        for (int t = 0; t < nt; t += 2) {
            const bool last = (t == nt - 2);
            const char* a1 = cA + (size_t)(t + 1) * kstep;
            const char* a2 = last ? nA : cA + (size_t)(t + 2) * kstep; const char* b2 = last ? nB : cB + (size_t)(t + 2) * kstep;
            const char* a3 = a2 + kstep; const char* b3 = b2 + kstep;
            PG8_LDB(B0, 0, 0); PG8_LDB(B1, 0, 1); PG8_SCHED; PG8_LDA(At, 0, 0); PG8_STAGE(PG8_SA(1, 1), a1 + hstepA, voffA);
            PG8_WAIT_V(8); PG8_WAIT_L(0); PG8_BAR; PG8_MMA(0, 0, At, B0); PG8_MMA(0, 1, At, B1); PG8_BAR; PG8_SCHED;
            PG8_LDA(At, 0, 1); PG8_STAGE(PG8_SB(0, 0), b2, voffB); PG8_STAGE(PG8_SB(0, 1), b2 + hstepB, voffB); PG8_STAGE(PG8_SA(0, 0), a2, voffA);
            PG8_WAIT_V(8); PG8_WAIT_L(0); PG8_BAR; PG8_MMA(1, 0, At, B0); PG8_MMA(1, 1, At, B1); PG8_BAR; PG8_SCHED;
            PG8_LDB(B0, 1, 0); PG8_LDB(B1, 1, 1); PG8_SCHED; PG8_LDA(At, 1, 0); PG8_STAGE(PG8_SA(0, 1), a2 + hstepA, voffA);
            PG8_WAIT_V(8); PG8_WAIT_L(0); PG8_BAR; PG8_MMA(0, 0, At, B0); PG8_MMA(0, 1, At, B1); PG8_BAR; PG8_SCHED;
            PG8_LDA(At, 1, 1); PG8_STAGE(PG8_SB(1, 0), b3, voffB); PG8_STAGE(PG8_SB(1, 1), b3 + hstepB, voffB); PG8_STAGE(PG8_SA(1, 0), a3, voffA);
            PG8_WAIT_V(8); PG8_WAIT_L(0); PG8_BAR; PG8_MMA(1, 0, At, B0); PG8_MMA(1, 1, At, B1); PG8_BAR; PG8_SCHED;
        }
        if (wr == 0) PG8_BAR;
        E(acc, cur, wr, wc, fr, fq);
        if (!has_next) break;
#pragma unroll
        for (int a = 0; a < 2; ++a)
#pragma unroll
            for (int b = 0; b < 2; ++b)
#pragma unroll
                for (int m = 0; m < 4; ++m)
#pragma unroll
                    for (int n = 0; n < 2; ++n) acc[a][b][m][n] = (f32x4){0.f, 0.f, 0.f, 0.f};
        cur = nxt; cA = nA; cB = nB; ++ui;
        if (wr == 1) PG8_BAR;
    }
    PG8_WAIT_V(0);
    PG8_BAR;
#undef PG8_SA
#undef PG8_SB
#undef PG8_STAGE
#undef PG8_LDA
#undef PG8_LDB
#undef PG8_MMA
#undef PG8_WAIT_V
#undef PG8_WAIT_L
#undef PG8_BAR
#undef PG8_SCHED
}

struct EpiStore16 {
    static constexpr bool PERM = true;
    bf16_t* O; int ldc;
    __device__ __forceinline__ void operator()(const f32x4 (&acc)[2][2][4][2], const Unit& u, int wr, int wc, int fr, int fq) const {
#pragma unroll
        for (int ai = 0; ai < 2; ++ai)
#pragma unroll
            for (int m = 0; m < 4; ++m) {
                bf16_t* rowp = O + (size_t)(u.pm * BM + ai * HALF + wr * 64 + m * 16 + fr) * ldc + u.pn * BM + wc * 32 + 8 * fq;
#pragma unroll
                for (int bj = 0; bj < 2; ++bj) { const f32x4 v0 = acc[ai][bj][m][0], v1 = acc[ai][bj][m][1];
                    u32x4 w; w.x = pk2(v0[0], v0[1]); w.y = pk2(v0[2], v0[3]); w.z = pk2(v1[0], v1[1]); w.w = pk2(v1[2], v1[3]);
                    *(u32x4*)(rowp + bj * HALF) = w; }
            }
    }
};
struct EpiStoreKV {
    static constexpr bool PERM = true;
    bf16_t* O; int ldc; const bf16_t* Zc;
    __device__ __forceinline__ void operator()(const f32x4 (&acc)[2][2][4][2], const Unit& u, int wr, int wc, int fr, int fq) const {
#pragma unroll
        for (int ai = 0; ai < 2; ++ai)
#pragma unroll
            for (int m = 0; m < 4; ++m) {
                const int row = u.pm * BM + ai * HALF + wr * 64 + m * 16 + fr;
                const bf16_t* zr = Zc + (size_t)row * ZLD + 64 * fq;
                float ss = 0.f;
#pragma unroll
                for (int c = 0; c < 8; ++c) { const u32x4 v = *(const u32x4*)(zr + 8 * c);
                    ss += (bflo(v.x) * bflo(v.x) + bfhi(v.x) * bfhi(v.x)) + (bflo(v.y) * bflo(v.y) + bfhi(v.y) * bfhi(v.y)) + (bflo(v.z) * bflo(v.z) + bfhi(v.z) * bfhi(v.z)) + (bflo(v.w) * bflo(v.w) + bfhi(v.w) * bfhi(v.w)); }
                ss += __shfl_xor(ss, 16); ss += __shfl_xor(ss, 32);
                const float r = rsqrtf(ss * (1.0f / 256.0f) + EPS);
                bf16_t* rowp = O + (size_t)row * ldc + u.pn * BM + wc * 32 + 8 * fq;
#pragma unroll
                for (int bj = 0; bj < 2; ++bj) { const f32x4 v0 = acc[ai][bj][m][0] * r, v1 = acc[ai][bj][m][1] * r;
                    u32x4 w; w.x = pk2(v0[0], v0[1]); w.y = pk2(v0[2], v0[3]); w.z = pk2(v1[0], v1[1]); w.w = pk2(v1[2], v1[3]);
                    *(u32x4*)(rowp + bj * HALF) = w; }
            }
    }
};
struct EpiStore {
    static constexpr bool PERM = true;
    bf16_t* O; int ldc; int ncols; int rope_mode; const float* cosT; const float* sinT;
    __device__ __forceinline__ void operator()(const f32x4 (&acc)[2][2][4][2], const Unit& u, int wr, int wc, int fr, int fq) const {
#pragma unroll
        for (int bj = 0; bj < 2; ++bj) {
            const int cg0 = u.pn * BM + bj * HALF + wc * 32;
            if (cg0 >= ncols) continue;
            const bool rope = (rope_mode == 1) ? (cg0 == ZC_KR) : (rope_mode == 2 ? (((cg0 >> 5) % 3) == 2) : false);
#pragma unroll
            for (int ai = 0; ai < 2; ++ai)
#pragma unroll
                for (int m = 0; m < 4; ++m) {
                    const int row = u.pm * BM + ai * HALF + wr * 64 + m * 16 + fr;
                    f32x4 v0 = acc[ai][bj][m][0], v1 = acc[ai][bj][m][1];
                    if (rope) {
                        const int s = row & (SEQ - 1), ib = 8 * (fq & 1);
                        const f32x4 c0 = *(const f32x4*)(cosT + s * 16 + ib), c1 = *(const f32x4*)(cosT + s * 16 + ib + 4);
                        const f32x4 s0 = *(const f32x4*)(sinT + s * 16 + ib), s1 = *(const f32x4*)(sinT + s * 16 + ib + 4);
                        f32x4 p0, p1;
#pragma unroll
                        for (int e = 0; e < 4; ++e) { p0[e] = __shfl_xor(v0[e], 32); p1[e] = __shfl_xor(v1[e], 32); }
                        if (fq < 2) { v0 = v0 * c0 - p0 * s0; v1 = v1 * c1 - p1 * s1; }
                        else        { v0 = p0 * s0 + v0 * c0; v1 = p1 * s1 + v1 * c1; }
                    }
                    u32x4 w; w.x = pk2(v0[0], v0[1]); w.y = pk2(v0[2], v0[3]); w.z = pk2(v1[0], v1[1]); w.w = pk2(v1[2], v1[3]);
                    *(u32x4*)(O + (size_t)row * ldc + cg0 + 8 * fq) = w;
                }
        }
    }
};

struct EpiNorm {
    static constexpr bool PERM = true;
    const float* xin; float* xout; bf16_t* XN;
    const float* gpost; const float* gpre; const float* modb; int gate_off, sc_off, sh_off;
    float* slot1; unsigned* cnt1; float* slot2; unsigned* cnt2;
    LAS unsigned char* xl;
    __device__ __forceinline__ void rowstat(const f32x4 (&v)[2][2][4][2], const Unit& u, int wr, int wc, int fr, int fq, float* slot, unsigned* cnt) const {
        LAS float* Pp = (LAS float*)xl; LAS float* S = (LAS float*)(xl + 4096);
        const int wid = wr * 4 + wc, tid = wid * 64 + fq * 16 + fr;
#pragma unroll
        for (int ai = 0; ai < 2; ++ai)
#pragma unroll
            for (int m = 0; m < 4; ++m) {
                float ss = 0.f;
#pragma unroll
                for (int bj = 0; bj < 2; ++bj)
#pragma unroll
                    for (int n = 0; n < 2; ++n) { const f32x4 x = v[ai][bj][m][n]; ss += (x[0] * x[0] + x[1] * x[1]) + (x[2] * x[2] + x[3] * x[3]); }
                ss += __shfl_xor(ss, 16); ss += __shfl_xor(ss, 32);
                if (fq == 0) Pp[(ai * HALF + wr * 64 + m * 16 + fr) * 4 + wc] = ss;
            }
        asm volatile("s_waitcnt lgkmcnt(0)" ::: "memory"); __builtin_amdgcn_s_barrier(); asm volatile("" ::: "memory");
        if (tid < 256) {
            const float tot = (Pp[tid * 4 + 0] + Pp[tid * 4 + 1]) + (Pp[tid * 4 + 2] + Pp[tid * 4 + 3]);
            __hip_atomic_store(slot + ((size_t)u.pm * BM + tid) * 4 + u.pn, tot, __ATOMIC_RELAXED, __HIP_MEMORY_SCOPE_AGENT);
        }
        asm volatile("s_waitcnt vmcnt(0)" ::: "memory");
        if (wid < 4 && (tid & 63) == 0) __hip_atomic_fetch_add(cnt + 64 * u.pm, 1u, __ATOMIC_RELAXED, __HIP_MEMORY_SCOPE_AGENT);
        if (wid == 0) {
            unsigned sp = 0;
            while ((unsigned)__builtin_amdgcn_readfirstlane(__hip_atomic_load(cnt + 64 * u.pm, __ATOMIC_RELAXED, __HIP_MEMORY_SCOPE_AGENT)) < 16u) { __builtin_amdgcn_s_sleep(2); if (++sp > (1u << 20)) break; }
            __builtin_amdgcn_fence(__ATOMIC_ACQUIRE, "agent");
        }
        asm volatile("s_waitcnt vmcnt(0) lgkmcnt(0)" ::: "memory"); __builtin_amdgcn_s_barrier(); asm volatile("" ::: "memory");
        if (tid < 256) {
            const float* sp4 = slot + ((size_t)u.pm * BM + tid) * 4;
            const float t0 = __hip_atomic_load(sp4 + 0, __ATOMIC_RELAXED, __HIP_MEMORY_SCOPE_AGENT), t1 = __hip_atomic_load(sp4 + 1, __ATOMIC_RELAXED, __HIP_MEMORY_SCOPE_AGENT);
            const float t2 = __hip_atomic_load(sp4 + 2, __ATOMIC_RELAXED, __HIP_MEMORY_SCOPE_AGENT), t3 = __hip_atomic_load(sp4 + 3, __ATOMIC_RELAXED, __HIP_MEMORY_SCOPE_AGENT);
            S[tid] = rsqrtf(((t0 + t1) + (t2 + t3)) * (1.0f / DM) + EPS);
        }
        asm volatile("s_waitcnt vmcnt(0) lgkmcnt(0)" ::: "memory"); __builtin_amdgcn_s_barrier(); asm volatile("" ::: "memory");
    }
    __device__ __forceinline__ void operator()(f32x4 (&acc)[2][2][4][2], const Unit& u, int wr, int wc, int fr, int fq) const {
        const LAS float* S = (const LAS float*)(xl + 4096);
        const float* md = modb + (size_t)(u.pm >> 4) * 6144;
        rowstat(acc, u, wr, wc, fr, fq, slot1, cnt1);
#pragma unroll
        for (int bj = 0; bj < 2; ++bj)
#pragma unroll
            for (int n = 0; n < 2; ++n) {
                const int col = u.pn * BM + bj * HALF + wc * 32 + 8 * fq + 4 * n;
                const f32x4 gg = *(const f32x4*)(md + gate_off + col) * *(const f32x4*)(gpost + col);
#pragma unroll
                for (int ai = 0; ai < 2; ++ai)
#pragma unroll
                    for (int m = 0; m < 4; ++m) {
                        const int rl = ai * HALF + wr * 64 + m * 16 + fr; const size_t off = (size_t)(u.pm * BM + rl) * DM + col;
                        const f32x4 xv = *(const f32x4*)(xin + off);
                        const f32x4 xn = xv + gg * (acc[ai][bj][m][n] * S[rl]);
                        acc[ai][bj][m][n] = xn; *(f32x4*)(xout + off) = xn;
                    }
            }
        if (XN == nullptr) return;
        asm volatile("s_waitcnt lgkmcnt(0)" ::: "memory"); __builtin_amdgcn_s_barrier(); asm volatile("" ::: "memory");
        rowstat(acc, u, wr, wc, fr, fq, slot2, cnt2);
#pragma unroll
        for (int bj = 0; bj < 2; ++bj) {
            const int col = u.pn * BM + bj * HALF + wc * 32 + 8 * fq;
            f32x4 mp[2], sh[2];
#pragma unroll
            for (int n = 0; n < 2; ++n) { mp[n] = *(const f32x4*)(gpre + col + 4 * n) * (*(const f32x4*)(md + sc_off + col + 4 * n) + 1.0f); sh[n] = *(const f32x4*)(md + sh_off + col + 4 * n); }
#pragma unroll
            for (int ai = 0; ai < 2; ++ai)
#pragma unroll
                for (int m = 0; m < 4; ++m) {
                    const int rl = ai * HALF + wr * 64 + m * 16 + fr; const float r = S[rl];
                    const f32x4 h0 = (acc[ai][bj][m][0] * r) * mp[0] + sh[0], h1 = (acc[ai][bj][m][1] * r) * mp[1] + sh[1];
                    u32x4 w; w.x = pk2(h0[0], h0[1]); w.y = pk2(h0[2], h0[3]); w.z = pk2(h1[0], h1[1]); w.w = pk2(h1[2], h1[3]);
                    *(u32x4*)(XN + (size_t)(u.pm * BM + rl) * DM + col) = w;
                }
        }
        asm volatile("s_waitcnt lgkmcnt(0)" ::: "memory"); __builtin_amdgcn_s_barrier(); asm volatile("" ::: "memory");
    }
};

struct EpiGate {
    static constexpr bool PERM = true;
    bf16_t* H; const bf16_t* G; const float* cw; const float* cb;
    __device__ __forceinline__ void operator()(const f32x4 (&acc)[2][2][4][2], const Unit& u, int wr, int wc, int fr, int fq) const {
#pragma unroll
        for (int bj = 0; bj < 2; ++bj) {
            const int col = u.pn * BM + bj * HALF + wc * 32 + 8 * fq;
            f32x4 w0[2], w1[2], w2[2], bb[2];
#pragma unroll
            for (int n = 0; n < 2; ++n) { w0[n] = *(const f32x4*)(cw + col + 4 * n); w1[n] = *(const f32x4*)(cw + DFF + col + 4 * n); w2[n] = *(const f32x4*)(cw + 2 * DFF + col + 4 * n); bb[n] = *(const f32x4*)(cb + col + 4 * n); }
#pragma unroll
            for (int ai = 0; ai < 2; ++ai)
#pragma unroll
                for (int m = 0; m < 4; ++m) {
                    const int row = u.pm * BM + ai * HALF + wr * 64 + m * 16 + fr;
                    const int t = row & (SEQ - 1);
                    const bf16_t* gp = G + (size_t)row * DFF + col;
                    const bool hasm = t > 0, hasn = t < SEQ - 1;
                    u32x4 gm = *(const u32x4*)(gp - (hasm ? DFF : 0));
                    const u32x4 g0 = *(const u32x4*)gp;
                    u32x4 gn = *(const u32x4*)(gp + (hasn ? DFF : 0));
                    const unsigned mm = hasm ? 0xffffffffu : 0u, mn = hasn ? 0xffffffffu : 0u;
                    gm.x &= mm; gm.y &= mm; gm.z &= mm; gm.w &= mm; gn.x &= mn; gn.y &= mn; gn.z &= mn; gn.w &= mn;
                    unsigned ow[4];
#pragma unroll
                    for (int n = 0; n < 2; ++n) {
                        const unsigned m0 = n ? gm.z : gm.x, m1 = n ? gm.w : gm.y, c0 = n ? g0.z : g0.x, c1 = n ? g0.w : g0.y, n0 = n ? gn.z : gn.x, n1 = n ? gn.w : gn.y;
                        const f32x4 fm = {bflo(m0), bfhi(m0), bflo(m1), bfhi(m1)}, f0 = {bflo(c0), bfhi(c0), bflo(c1), bfhi(c1)}, fn = {bflo(n0), bfhi(n0), bflo(n1), bfhi(n1)};
                        const f32x4 gc = bb[n] + fm * w0[n] + f0 * w1[n] + fn * w2[n];
                        const f32x4 a = acc[ai][bj][m][n];
                        float o[4];
#pragma unroll
                        for (int e = 0; e < 4; ++e) {
                            constexpr float C1 = -2.0f * LOG2E * 0.7978845608028654f, C2 = C1 * 0.044715f;
                            const float x = gc[e];
                            const float ex = __builtin_amdgcn_exp2f(x * __builtin_fmaf(x * x, C2, C1));
                            o[e] = (x * a[e]) * __builtin_amdgcn_rcpf(1.0f + ex);
                        }
                        ow[2 * n] = pk2(o[0], o[1]); ow[2 * n + 1] = pk2(o[2], o[3]);
                    }
                    *(u32x4*)(H + (size_t)row * DFF + col) = (u32x4){ow[0], ow[1], ow[2], ow[3]};
                }
        }
    }
};
}

__device__ __forceinline__ s16x4 vtr(LAS const unsigned char* p) { typedef short v4i16_t __attribute__((ext_vector_type(4))); return __builtin_bit_cast(s16x4, __builtin_amdgcn_ds_read_tr16_b64_v4i16((LAS v4i16_t*)p)); }

template <int NK, int NT, int KSTR, class BM>
__device__ __forceinline__ void attn_step(LAS const unsigned char* Kl, LAS const unsigned char* Vl, int kb, const bf16x8 (&q)[NT][NK], f32x4 (&o)[NT][4], float (&mrun)[NT], float (&lrun)[NT], int lane, const BM& bm) {
    constexpr float THR = 8.0f;
    const int i = lane & 15, g = lane >> 4;
    f32x4 s0[NT], s1[NT];
#pragma unroll
    for (int t = 0; t < NT; ++t) { const float nm = -mrun[t]; s0[t] = (f32x4){nm, nm, nm, nm}; s1[t] = s0[t]; }
    LAS const unsigned char* kp = Kl + (kb + i) * KSTR + g * 16;
#pragma unroll
    for (int ks = 0; ks < NK; ++ks) {
        const bf16x8 a0 = *(LAS const bf16x8*)(kp + ks * 64);
        const bf16x8 a1 = *(LAS const bf16x8*)(kp + 16 * KSTR + ks * 64);
#pragma unroll
        for (int t = 0; t < NT; ++t) {
            s0[t] = __builtin_amdgcn_mfma_f32_16x16x32_bf16(a0, q[t][ks], s0[t], 0, 0, 0);
            s1[t] = __builtin_amdgcn_mfma_f32_16x16x32_bf16(a1, q[t][ks], s1[t], 0, 0, 0);
        }
    }
    bf16x8 pb[NT];
#pragma unroll
    for (int t = 0; t < NT; ++t) {
        bm(s0[t], s1[t], kb, t);
        float mx = fmaxf(fmaxf(fmaxf(s0[t][0], s0[t][1]), fmaxf(s0[t][2], s0[t][3])), fmaxf(fmaxf(s1[t][0], s1[t][1]), fmaxf(s1[t][2], s1[t][3])));
        if (__any(mx > THR)) {
            mx = fmaxf(mx, __shfl_xor(mx, 16)); mx = fmaxf(mx, __shfl_xor(mx, 32));
            const float dl = fmaxf(mx, 0.f);
            const float alpha = __builtin_amdgcn_exp2f(-dl);
            mrun[t] += dl; lrun[t] *= alpha;
#pragma unroll
            for (int db = 0; db < 4; ++db) o[t][db] = o[t][db] * alpha;
            s0[t] = s0[t] - dl; s1[t] = s1[t] - dl;
        }
        float p0[4], p1[4]; float ps = 0.f;
#pragma unroll
        for (int j = 0; j < 4; ++j) { p0[j] = __builtin_amdgcn_exp2f(s0[t][j]); p1[j] = __builtin_amdgcn_exp2f(s1[t][j]); ps += p0[j] + p1[j]; }
        lrun[t] += ps;
        u32x4 w; w.x = pk2(p0[0], p0[1]); w.y = pk2(p0[2], p0[3]); w.z = pk2(p1[0], p1[1]); w.w = pk2(p1[2], p1[3]);
        pb[t] = __builtin_bit_cast(bf16x8, w);
    }
    LAS const unsigned char* vp = Vl + (kb + 4 * g + (i >> 2)) * S64 + (i & 3) * 8;
#pragma unroll
    for (int db = 0; db < 4; ++db) {
        const s16x4 lo = vtr(vp + db * 32), hi = vtr(vp + 16 * S64 + db * 32);
        const bf16x8 va = {lo[0], lo[1], lo[2], lo[3], hi[0], hi[1], hi[2], hi[3]};
#pragma unroll
        for (int t = 0; t < NT; ++t) o[t][db] = __builtin_amdgcn_mfma_f32_16x16x32_bf16(va, pb[t], o[t][db], 0, 0, 0);
    }
}

__device__ __forceinline__ bf16x8 load_q(const bf16_t* p, float s) { const u32x4 v = *(const u32x4*)p; return __builtin_bit_cast(bf16x8, scale_bf8(v, s)); }

struct Params { const float* in[20]; float* out; unsigned char* ws; };
enum { I_X = 0, I_C, I_WADA, I_BADA, I_GPREMIX, I_GPOSTMIX, I_GPREFFN, I_GPOSTFFN, I_WIN, I_RPB, I_T5, I_GQ, I_GKV, I_WUQ, I_WUKV, I_WOUT, I_WUP, I_CONVW, I_CONVB, I_WDOWN };

__device__ const unsigned char T5B[3][65] = {
 {0,1,2,3,4,5,6,7,8,8,8,8,8,8,8,9,9,9,9,9,9,9,9,9,9,9,9,10,10,10,10,10,10,10,10,10,10,10,10,10,10,10,10,10,10,10,10,10,10,10,11,11,11,11,11,11,11,11,11,11,11,11,11,11,11},
 {0,4,8,8,9,9,9,10,10,10,10,10,10,11,11,11,11,11,11,11,11,11,11,12,12,12,12,12,12,12,12,12,12,12,12,12,12,12,12,12,12,12,13,13,13,13,13,13,13,13,13,13,13,13,13,13,13,13,13,13,13,13,13,13,13},
 {0,9,10,10,11,11,12,12,12,12,12,13,13,13,13,13,13,13,13,13,14,14,14,14,14,14,14,14,14,14,14,14,14,14,14,15,15,15,15,15,15,15,15,15,15,15,15,15,15,15,15,15,15,15,15,15,15,15,15,15,15,15,15,15,15}};

__device__ __forceinline__ void transpose_item(const float* W, int K, int N, bf16_t* WT, const float* ksc, LAS float* scr, int item, int lane) {
    const int nblk = N / 32, kb = item / nblk, nb = item % nblk, k0 = 64 * kb, n0 = 32 * nb;
#pragma unroll 8
    for (int i = 0; i < 32; ++i) { const int kk = 2 * i + (lane >> 5); float v = W[(size_t)(k0 + kk) * N + n0 + (lane & 31)]; if (ksc) v *= ksc[k0 + kk]; scr[kk * 33 + (lane & 31)] = v; }
    asm volatile("s_waitcnt lgkmcnt(0)" ::: "memory");
    const int c = lane & 7;
#pragma unroll
    for (int j = 0; j < 4; ++j) { const int n = (lane >> 3) + 8 * j; const LAS float* s = scr + (8 * c) * 33 + n;
        u32x4 o; o.x = pk2(s[0 * 33], s[1 * 33]); o.y = pk2(s[2 * 33], s[3 * 33]); o.z = pk2(s[4 * 33], s[5 * 33]); o.w = pk2(s[6 * 33], s[7 * 33]);
        *(u32x4*)(WT + (size_t)(n0 + n) * K + k0 + 8 * c) = o; }
    asm volatile("s_waitcnt lgkmcnt(0)" ::: "memory");
}

template <int R>
__device__ __forceinline__ void rowwise_rows(int row0, int rstride, const float* xin, const bf16_t* y, const float* gpost, int gate_off, const float* modb, float* xout,
                                             const float* gpre, int sc_off, int sh_off, bf16_t* XN, int lane) {
    f32x4 v[R][4]; u32x2 yw[R][4];
#pragma unroll
    for (int r = 0; r < R; ++r) { const size_t ro = (size_t)(row0 + r * rstride) * DM + 4 * lane;
#pragma unroll
        for (int j = 0; j < 4; ++j) v[r][j] = *(const f32x4*)(xin + ro + 256 * j);
        if (y) {
#pragma unroll
            for (int j = 0; j < 4; ++j) yw[r][j] = *(const u32x2*)(y + ro + 256 * j); } }
#pragma unroll
    for (int r = 0; r < R; ++r) {
        const int row = row0 + r * rstride; const size_t ro = (size_t)row * DM + 4 * lane;
        const float* md = modb + (size_t)(row >> 12) * 6144;
        if (y) {
            f32x4 yv[4]; float ss = 0.f;
#pragma unroll
            for (int j = 0; j < 4; ++j) { const u32x2 w = yw[r][j]; yv[j] = (f32x4){bflo(w.x), bfhi(w.x), bflo(w.y), bfhi(w.y)};
                ss += (yv[j][0] * yv[j][0] + yv[j][1] * yv[j][1]) + (yv[j][2] * yv[j][2] + yv[j][3] * yv[j][3]); }
            const float rr = rsqrtf(wave_sum(ss) * (1.0f / DM) + EPS);
#pragma unroll
            for (int j = 0; j < 4; ++j) { const f32x4 gp = *(const f32x4*)(gpost + 4 * lane + 256 * j), gt = *(const f32x4*)(md + gate_off + 4 * lane + 256 * j);
                v[r][j] = v[r][j] + gt * (yv[j] * rr * gp); }
        }
        if (xout) {
#pragma unroll
            for (int j = 0; j < 4; ++j) *(f32x4*)(xout + ro + 256 * j) = v[r][j];
        }
        if (XN) {
            float ss = 0.f;
#pragma unroll
            for (int j = 0; j < 4; ++j) ss += (v[r][j][0] * v[r][j][0] + v[r][j][1] * v[r][j][1]) + (v[r][j][2] * v[r][j][2] + v[r][j][3] * v[r][j][3]);
            const float rr = rsqrtf(wave_sum(ss) * (1.0f / DM) + EPS);
#pragma unroll
            for (int j = 0; j < 4; ++j) { const f32x4 gp = *(const f32x4*)(gpre + 4 * lane + 256 * j), s1 = *(const f32x4*)(md + sc_off + 4 * lane + 256 * j), s0 = *(const f32x4*)(md + sh_off + 4 * lane + 256 * j);
                const f32x4 h = (v[r][j] * rr * gp) * (s1 + 1.0f) + s0;
                u32x2 w; w.x = pk2(h[0], h[1]); w.y = pk2(h[2], h[3]); *(u32x2*)(XN + ro + 256 * j) = w; }
        }
    }
}

#define XB_TMO      128
#define XB_XCNT(j)  (256  + 64 * (j))
#define XB_XSUB(j)  (1280 + 64 * (j))
#define XB_XGEN(j)  (2304 + 64 * (j))
#define XB_TOP      3328
#define XB_TOPGEN   3392
#define XCD_BAR_WORDS 3456
#define XB_SPIN_CAP (1u << 20)
__device__ __forceinline__ unsigned xb_ld(unsigned* p)              { return __hip_atomic_load(p, __ATOMIC_RELAXED, __HIP_MEMORY_SCOPE_AGENT); }
__device__ __forceinline__ unsigned xb_add(unsigned* p, unsigned v) { return __hip_atomic_fetch_add(p, v, __ATOMIC_RELAXED, __HIP_MEMORY_SCOPE_AGENT); }
__device__ __forceinline__ unsigned xb_xcc_id() { return (unsigned)__builtin_amdgcn_s_getreg((3 << 11) | 20) & 0xFu; }
#define XB_SPIN(cond, bar) do { unsigned _sp = 0; while (cond) { __builtin_amdgcn_s_sleep(1); \
    if ((++_sp & 255u) == 0u) { if (xb_ld(&(bar)[XB_TMO])) break; if (_sp > XB_SPIN_CAP) { atomicAdd(&(bar)[XB_TMO], 1u); break; } } } } while (0)
struct XcdBarrier { unsigned* bar; unsigned x; volatile LAS unsigned* st; };
__device__ __forceinline__ XcdBarrier xcd_barrier_post(unsigned* bar, volatile LAS unsigned* st, int wave_s) {
    XcdBarrier b; b.bar = bar; b.x = xb_xcc_id(); b.st = st;
    if (flat_tid(wave_s) == 0) (void)xb_add(&bar[XB_XCNT(b.x)], 1u);
    return b;
}
__device__ __forceinline__ void xcd_barrier_complete(unsigned* bar, unsigned x, unsigned& nloc, unsigned& nx) {
    const unsigned G = gridDim.x * gridDim.y * gridDim.z;
    unsigned sum, cnt, mine, sp = 0u;
    for (;;) {
        sum = 0u; cnt = 0u; mine = 0u;
#pragma unroll
        for (unsigned j = 0; j < 16; ++j) { const unsigned c = xb_ld(&bar[XB_XCNT(j)]); sum += c; cnt += (c > 0u) ? 1u : 0u; mine = (j == x) ? c : mine; }
        if (sum == G) break;
        __builtin_amdgcn_s_sleep(1);
        if ((++sp & 255u) == 0u) { if (xb_ld(&bar[XB_TMO])) break; if (sp > XB_SPIN_CAP) { atomicAdd(&bar[XB_TMO], 1u); break; } }
    }
    nloc = mine > 0u ? mine : 1u; nx = cnt > 0u ? cnt : 1u;
}
__device__ __forceinline__ void xcd_barrier(const XcdBarrier& b, int wave_s) {
    asm volatile("s_waitcnt vmcnt(0)" ::: "memory");
    __syncthreads();
    if (flat_tid(wave_s) == 0) {
        unsigned* bar = b.bar; unsigned bx = b.x;
        asm volatile("" : "+s"(bx));
        __builtin_amdgcn_s_waitcnt(0);
        unsigned nloc = b.st[0], nx = b.st[1];
        if (nloc == 0u) { xcd_barrier_complete(bar, bx, nloc, nx); b.st[0] = nloc; b.st[1] = nx; }
        const unsigned old = xb_add(&bar[XB_XSUB(bx)], 1u);
        const unsigned gen = old / nloc;
        if (old + 1u == (gen + 1u) * nloc) {
            __builtin_amdgcn_fence(__ATOMIC_RELEASE, "agent");
            asm volatile("s_waitcnt vmcnt(0)" ::: "memory");
            const unsigned og = xb_add(&bar[XB_TOP], 1u);
            const unsigned tg = og / nx;
            if (og + 1u == (tg + 1u) * nx) xb_add(&bar[XB_TOPGEN], 1u);
            else XB_SPIN(xb_ld(&bar[XB_TOPGEN]) == tg, bar);
            __builtin_amdgcn_fence(__ATOMIC_ACQUIRE, "agent");
            xb_add(&bar[XB_XGEN(bx)], 1u);
            asm volatile("s_waitcnt vmcnt(0)" ::: "memory");
        } else {
            XB_SPIN(xb_ld(&bar[XB_XGEN(bx)]) == gen, bar);
            __builtin_amdgcn_fence(__ATOMIC_ACQUIRE, "agent");
            asm volatile("s_waitcnt vmcnt(0)" ::: "memory");
        }
    }
    __syncthreads();
}

constexpr int LDS_BYTES = 148 * 1024;

__global__ void __launch_bounds__(NTHR, 2) fwd_megakernel(Params P) {
    extern __shared__ __attribute__((aligned(16))) unsigned char lds_raw[];
    LAS unsigned char* lds = (LAS unsigned char*)lds_raw;
    cg::grid_group grid = cg::this_grid();
    volatile LAS unsigned* MISC = (volatile LAS unsigned*)(lds + 3 * 128 * (S96 + S64) + 64);
    const int wave_s = __builtin_amdgcn_readfirstlane((int)threadIdx.x >> 6);
    const int tid0 = flat_tid(wave_s);
    if (tid0 < 32) MISC[tid0] = 0u;
    unsigned* barw = (unsigned*)(P.ws + WS_BAR);
    if (blockIdx.x == 0) for (int i = tid0; i < XCD_BAR_WORDS; i += NTHR) __hip_atomic_store(barw + i, 0u, __ATOMIC_RELAXED, __HIP_MEMORY_SCOPE_AGENT);
    { unsigned* xc = (unsigned*)(P.ws + WS_XCNT); for (int i = blockIdx.x * NTHR + tid0; i < 16 * 256 * 64; i += gridDim.x * NTHR) __hip_atomic_store(xc + i, 0u, __ATOMIC_RELAXED, __HIP_MEMORY_SCOPE_AGENT); }
    asm volatile("s_waitcnt vmcnt(0)" ::: "memory");
    __syncthreads();
    grid.sync();
    __builtin_amdgcn_fence(__ATOMIC_ACQUIRE, "agent");
    asm volatile("s_waitcnt vmcnt(0)" ::: "memory");
    const XcdBarrier xbar = xcd_barrier_post(barw, MISC + 8, wave_s);
#define GSYNC() xcd_barrier(xbar, wave_s)
    const int G = gridDim.x, bid = blockIdx.x, NGW = G * NWAVE;
#define LOCAL_IDS int tid = flat_tid(wave_s); asm volatile("" : "+v"(tid)); const int lane = tid & 63, wave = __builtin_amdgcn_readfirstlane(tid >> 6), gw = bid * NWAVE + wave; (void)lane; (void)gw;
    unsigned char* ws = P.ws;
    float* modp = (float*)(ws + WS_MOD);
    float* cosT = (float*)(ws + WS_ROPE); float* sinT = cosT + SEQ * 16;
    float* rq = (float*)(ws + WS_RQ); float* rkv = rq + MTOK;
    float* lutg = (float*)(ws + WS_LUT);
    float* lse = (float*)(ws + WS_LSE);
    bf16_t* XN = (bf16_t*)(ws + WS_XN);
    bf16_t* Z = (bf16_t*)(ws + WS_Z);
    bf16_t* QB = (bf16_t*)(ws + WS_Q);
    bf16_t* KVB = (bf16_t*)(ws + WS_KV);
    bf16_t* PART = (bf16_t*)(ws + WS_PART);
    bf16_t* OB = XN;
    bf16_t* YMIX = Z;
    bf16_t* GB = (bf16_t*)(ws + WS_G);
    bf16_t* HID = (bf16_t*)(ws + WS_HID);
    bf16_t* YFFN = XN;

    {
        LOCAL_IDS
        LAS float* scr = (LAS float*)(lds + wave * 16384);
        constexpr int IT_IN = 16 * 93, IT_OUT = 16 * 32, IT_UP = 16 * 176, IT_DOWN = 44 * 32, IT_UQ = 6 * 12, IT_UKV = 4 * 16;
        constexpr int IT_L = IT_IN + IT_OUT + IT_UP + IT_DOWN + IT_UQ + IT_UKV;
        for (int it = gw; it < DEPTH * IT_L; it += NGW) {
            const int l = it / IT_L; int r = it % IT_L;
            unsigned char* wl = ws + WS_W + (size_t)l * WL_STRIDE;
            if (r < IT_IN) { transpose_item(P.in[I_WIN] + (size_t)l * DM * DIN, DM, DIN, (bf16_t*)(wl + WL_IN), nullptr, scr, r, lane); continue; } r -= IT_IN;
            if (r < IT_OUT) { transpose_item(P.in[I_WOUT] + (size_t)l * DM * DM, DM, DM, (bf16_t*)(wl + WL_OUT), nullptr, scr, r, lane); continue; } r -= IT_OUT;
            if (r < IT_UP) { transpose_item(P.in[I_WUP] + (size_t)l * DM * 2 * DFF, DM, 2 * DFF, (bf16_t*)(wl + WL_UP), nullptr, scr, r, lane); continue; } r -= IT_UP;
            if (r < IT_DOWN) { transpose_item(P.in[I_WDOWN] + (size_t)l * DFF * DM, DFF, DM, (bf16_t*)(wl + WL_DOWN), nullptr, scr, r, lane); continue; } r -= IT_DOWN;
            if (r < IT_UQ) { transpose_item(P.in[I_WUQ] + (size_t)l * 384 * 384, 384, 384, (bf16_t*)(wl + WL_UQ), P.in[I_GQ] + l * 384, scr, r, lane); continue; } r -= IT_UQ;
            transpose_item(P.in[I_WUKV] + (size_t)l * 256 * 512, 256, 512, (bf16_t*)(wl + WL_UKV), P.in[I_GKV] + l * 256, scr, r, lane);
        }
        {
            constexpr int PZ_IN = 96 * 1024 / 8, PZ_UQ = 128 * 384 / 8, PZ_L = PZ_IN + PZ_UQ;
            const u32x4 z4 = {0u, 0u, 0u, 0u};
            for (int it = bid * NTHR + tid; it < DEPTH * PZ_L; it += G * NTHR) {
                const int l = it / PZ_L, r = it % PZ_L;
                unsigned char* wl = ws + WS_W + (size_t)l * WL_STRIDE;
                if (r < PZ_IN) *(u32x4*)(wl + WL_IN + (size_t)DIN * DM * 2 + (size_t)r * 16) = z4;
                else *(u32x4*)(wl + WL_UQ + (size_t)384 * 384 * 2 + (size_t)(r - PZ_IN) * 16) = z4;
            }
        }
        for (int it = bid * NTHR + tid; it < SEQ * 16; it += G * NTHR) {
            const int s = it >> 4, i = it & 15;
            const float invf = powf(10000.0f, -(float)(2 * i) / 32.0f);
            const float ang = (float)s * invf;
            const double t = (double)ang * 0.15915494309189535;
            const float fr = (float)(t - floor(t));
            cosT[it] = __builtin_amdgcn_cosf(fr); sinT[it] = __builtin_amdgcn_sinf(fr);
        }
        for (int it = bid * NTHR + tid; it < 3 * 8 * 129; it += G * NTHR) {
            const int p = it / (8 * 129), h = (it / 129) % 8, idx = it % 129, rel = idx - 64, n = rel < 0 ? -rel : rel;
            const int bk = (int)T5B[p][n] + (rel > 0 ? 16 : 0);
            lutg[(p * 8 + h) * 132 + idx] = P.in[I_T5][bk * 8 + h] * LOG2E;
        }
        __syncthreads();
        for (int pair = bid; pair < 96; pair += G) {
            const int l = pair / 24, nc = pair % 24, ks = wave;
#pragma unroll 4
            for (int e = lane; e < 2048; e += 64) { const int b = e >> 7, k = e & 127; const float cv = P.in[I_C][b * DM + ks * 128 + k]; scr[e] = cv / (1.0f + __expf(-cv)); }
            asm volatile("s_waitcnt lgkmcnt(0)" ::: "memory");
            f32x4 accm[16];
#pragma unroll
            for (int b = 0; b < 16; ++b) accm[b] = (f32x4){0.f, 0.f, 0.f, 0.f};
            const float* wp = P.in[I_WADA] + ((size_t)l * DM + ks * 128) * 6144 + nc * 256 + 4 * lane;
#pragma unroll 4
            for (int k = 0; k < 128; ++k) {
                const f32x4 w = *(const f32x4*)(wp + (size_t)k * 6144);
#pragma unroll
                for (int b = 0; b < 16; ++b) accm[b] = accm[b] + w * scr[b * 128 + k];
            }
            asm volatile("s_waitcnt lgkmcnt(0)" ::: "memory");
#pragma unroll
            for (int b = 0; b < 16; ++b) *(LAS f32x4*)(scr + b * 256 + 4 * lane) = accm[b];
            __syncthreads();
            const LAS float* part = (const LAS float*)lds;
#pragma unroll
            for (int j = 0; j < 8; ++j) {
                const int o = tid + NTHR * j, b = o >> 8, n = o & 255;
                float sum = P.in[I_BADA][l * 6144 + nc * 256 + n];
#pragma unroll
                for (int w = 0; w < 8; ++w) sum += part[w * 4096 + o];
                modp[((size_t)l * 16 + b) * 6144 + nc * 256 + n] = sum;
            }
            __syncthreads();
        }
    }
    GSYNC();
    { LOCAL_IDS
    for (int row = gw; row < MTOK; row += 4 * NGW)
        rowwise_rows<4>(row, NGW, P.in[I_X], nullptr, nullptr, 0, modp, nullptr, P.in[I_GPREMIX], 1024, 0, XN, lane);
    }
    GSYNC();

    for (int l = 0; l < DEPTH; ++l) {
        unsigned char* wl = ws + WS_W + (size_t)l * WL_STRIDE;
        const float* modl = modp + (size_t)l * 16 * 6144;
        {
            pg8::Gemm g{XN, (const bf16_t*)(wl + WL_IN), MTOK, ZLD, DM, DM}; pg8::StaticOrder S; S.init(MTOK, ZLD, G, bid);
            pg8::EpiStore E{Z, ZLD, ZLD, 1, cosT, sinT};
            pg8::gemm_phase(lds, g, S, E, wave_s);
        }
        GSYNC();
        {
            pg8::Gemm g{Z + ZC_CQ, (const bf16_t*)(wl + WL_UQ), MTOK, 512, 384, ZLD}; pg8::StaticOrder S; S.init(MTOK, 512, G, bid);
            pg8::EpiStore E{QB, 384, 384, 2, cosT, sinT};
            pg8::gemm_phase(lds, g, S, E, wave_s);
        }
        {
            pg8::Gemm g{Z + ZC_CKV, (const bf16_t*)(wl + WL_UKV), MTOK, 512, 256, ZLD}; pg8::StaticOrder S; S.init(MTOK, 512, G, bid);
            pg8::EpiStoreKV E{KVB, 512, Z + ZC_CKV};
            pg8::gemm_phase(lds, g, S, E, wave_s);
        }
        { LOCAL_IDS
        for (int row0 = gw; row0 < MTOK; row0 += 4 * NGW) {
            u32x4 v0[4], v1[4];
#pragma unroll
            for (int r = 0; r < 4; ++r) { const bf16_t* zr = Z + (size_t)(row0 + r * NGW) * ZLD + ZC_CQ; v0[r] = *(const u32x4*)(zr + 8 * lane);
                v1[r] = (u32x4){0u, 0u, 0u, 0u}; if (lane < 16) v1[r] = *(const u32x4*)(zr + 8 * (lane + 64)); }
#pragma unroll
            for (int r = 0; r < 4; ++r) {
                const u32x4 a = v0[r], c = v1[r];
                const float s0 = bflo(a.x) * bflo(a.x) + bfhi(a.x) * bfhi(a.x) + bflo(a.y) * bflo(a.y) + bfhi(a.y) * bfhi(a.y) + bflo(a.z) * bflo(a.z) + bfhi(a.z) * bfhi(a.z) + bflo(a.w) * bflo(a.w) + bfhi(a.w) * bfhi(a.w);
                const float s1 = bflo(c.x) * bflo(c.x) + bfhi(c.x) * bfhi(c.x) + bflo(c.y) * bflo(c.y) + bfhi(c.y) * bfhi(c.y) + bflo(c.z) * bflo(c.z) + bfhi(c.z) * bfhi(c.z) + bflo(c.w) * bflo(c.w) + bfhi(c.w) * bfhi(c.w);
                float sq = lane < 48 ? s0 : 0.f, sk = (lane < 48 ? 0.f : s0) + s1;
                sq = wave_sum(sq); sk = wave_sum(sk);
                if (lane == 0) { const int row = row0 + r * NGW; rq[row] = rsqrtf(sq * (1.0f / 384.0f) + EPS); rkv[row] = rsqrtf(sk * (1.0f / 256.0f) + EPS); }
            }
        } }
        {
            LOCAL_IDS
            LAS unsigned char* Kl = lds; LAS unsigned char* Vl = lds + 400 * S64; LAS float* biasL = (LAS float*)(lds + 2 * 400 * S64);
            const int i = lane & 15, g4 = lane >> 4, w16 = 16 * wave;
            const int per = (24 * 256 + G - 1) / G, u0 = bid * per, u1 = min(u0 + per, 24 * 256);
            u32x4 pk[6], pvv[6], pq[2][2];
            if (tid < S64) { unsigned zz = 0u; asm volatile("" : "+v"(zz)); const u32x4 z4 = {zz, zz, zz, zz}; *(LAS u32x4*)(Kl + 384 * S64 + tid * 16) = z4; *(LAS u32x4*)(Vl + 384 * S64 + tid * 16) = z4; }
            auto decode = [&](int unit, int& p, int& h, int& b, int& r, int& mb, int& dl) {
                const int ph = unit >> 8, rest = unit & 255; p = ph >> 3; h = ph & 7; b = rest >> 4; const int rm = rest & 15;
                dl = 2 * p; const int nmb = 16 >> dl; r = rm / nmb; mb = rm % nmb; };
            auto issue = [&](int unit) {
                int p, h, b, r, mb, dl; decode(unit, p, h, b, r, mb, dl);
                const int L = SEQ >> dl;
                const bf16_t* zb = Z + (size_t)b * SEQ * ZLD + 64 * h;
#pragma unroll
                for (int it = 0; it < 6; ++it) {
                    const int c = tid + NTHR * it, row = c >> 3, ch = c & 7, mk = 256 * mb - 64 + row;
                    pk[it] = (u32x4){0u, 0u, 0u, 0u}; pvv[it] = (u32x4){0u, 0u, 0u, 0u};
                    if (mk >= 0 && mk < L) { const bf16_t* src = zb + (size_t)((mk << dl) + r) * ZLD + 8 * ch; pk[it] = *(const u32x4*)(src + ZC_KB); pvv[it] = *(const u32x4*)(src + ZC_VB); }
                }
#pragma unroll
                for (int t = 0; t < 2; ++t) { const int tq = ((256 * mb + 128 * t + w16 + i) << dl) + r;
                    const bf16_t* qp = zb + (size_t)tq * ZLD + ZC_QB + 8 * g4; pq[t][0] = *(const u32x4*)qp; pq[t][1] = *(const u32x4*)(qp + 32); }
            };
            auto commit = [&]() {
#pragma unroll
                for (int it = 0; it < 6; ++it) { const int c = tid + NTHR * it, row = c >> 3, ch = c & 7;
                    *(LAS u32x4*)(Kl + row * S64 + ch * 16) = pk[it]; *(LAS u32x4*)(Vl + row * S64 + ch * 16) = pvv[it]; }
            };
            int cur_ph = -1;
            issue(min(u0, 24 * 256 - 1));
            for (int unit = u0; unit < u1; ++unit) {
                int p, h, b, r, mb, dl; decode(unit, p, h, b, r, mb, dl);
                const int L = SEQ >> dl, nmb = 16 >> dl;
                commit();
                if ((unit >> 8) != cur_ph) {
                    cur_ph = unit >> 8;
                    const float* lg = lutg + cur_ph * 132;
                    for (int e = tid; e < 2560; e += NTHR) { const int st = e >> 9, ln = (e >> 3) & 63, jj = e & 7;
                        const int rel = 32 * st + 4 * (ln >> 4) + (jj & 3) + 16 * (jj >> 2) - 64 - (ln & 15); const bool ok = (rel >= -64) && (rel <= 64);
                        biasL[e] = ok ? lg[min(max(rel + 64, 0), 128)] : -INFINITY; }
                }
                bf16x8 qf[2][1][2]; f32x4 o[2][1][4]; float mr[2][1], lr[2][1];
#pragma unroll
                for (int t = 0; t < 2; ++t) {
                    qf[t][0][0] = __builtin_bit_cast(bf16x8, scale_bf8(pq[t][0], 0.125f * LOG2E)); qf[t][0][1] = __builtin_bit_cast(bf16x8, scale_bf8(pq[t][1], 0.125f * LOG2E));
                    mr[t][0] = 0.f; lr[t][0] = 0.f;
#pragma unroll
                    for (int db = 0; db < 4; ++db) o[t][0][db] = (f32x4){0.f, 0.f, 0.f, 0.f};
                }
                __syncthreads();
                if (unit + 1 < u1) issue(unit + 1);
                const bool edge = (mb == 0) || (mb == nmb - 1);
#pragma unroll 1
                for (int st = 0; st < 5; ++st) {
                    auto bm = [&](f32x4& s0, f32x4& s1, int kb, int) {
                        const LAS f32x4* bp = (const LAS f32x4*)(biasL + (st * 64 + lane) * 8);
                        s0 = s0 + bp[0]; s1 = s1 + bp[1];
                        if (edge) {
#pragma unroll
                            for (int j = 0; j < 4; ++j) { const int mk0 = 256 * mb - 64 + kb + 4 * g4 + j, mk1 = mk0 + 16;
                                if (mk0 < 0 || mk0 >= L) s0[j] = -INFINITY; if (mk1 < 0 || mk1 >= L) s1[j] = -INFINITY; }
                        }
                    };
#pragma unroll
                    for (int t = 0; t < 2; ++t) attn_step<2, 1, S64>(Kl, Vl, 128 * t + w16 + 32 * st, qf[t], o[t], mr[t], lr[t], lane, bm);
                }
#pragma unroll
                for (int t = 0; t < 2; ++t) {
                    const int tq = ((256 * mb + 128 * t + w16 + i) << dl) + r;
                    float lt = lr[t][0]; lt += __shfl_xor(lt, 16); lt += __shfl_xor(lt, 32);
                    const float inv = 1.0f / lt;
                    bf16_t* op = PART + ((size_t)p * MTOK + (size_t)b * SEQ + tq) * 512 + 64 * h + 4 * g4;
#pragma unroll
                    for (int db = 0; db < 4; ++db) { u32x2 w; w.x = pk2(o[t][0][db][0] * inv, o[t][0][db][1] * inv); w.y = pk2(o[t][0][db][2] * inv, o[t][0][db][3] * inv); *(u32x2*)(op + 16 * db) = w; }
                    if (g4 == 0) lse[((size_t)p * MTOK + (size_t)b * SEQ + tq) * 8 + h] = mr[t][0] + __log2f(lt);
                }
                __syncthreads();
            }
        }
        GSYNC();
        {
            LOCAL_IDS
            constexpr int KB_BYTES = 128 * S96, BUF_BYTES = 128 * S96 + 128 * S64;
            const int i = lane & 15, g4 = lane >> 4;
            const float qscale = 0.10206207261596575f * LOG2E;
            for (int unit = bid; unit < 1024; unit += G) {
                const int b = unit >> 6, h = (unit >> 4) & 3, qb = unit & 15;
                const size_t tb = (size_t)b * SEQ;
                bf16x8 qf[2][3];
#pragma unroll
                for (int t = 0; t < 2; ++t) { const size_t row = tb + qb * 256 + 32 * wave + 16 * t + i; const float sc = rq[row] * qscale;
                    const bf16_t* qp = QB + row * 384 + 96 * h + 8 * g4;
#pragma unroll
                    for (int ks = 0; ks < 3; ++ks) qf[t][ks] = load_q(qp + 32 * ks, sc); }
                f32x4 o[2][4];
#pragma unroll
                for (int t = 0; t < 2; ++t)
#pragma unroll
                    for (int db = 0; db < 4; ++db) o[t][db] = (f32x4){0.f, 0.f, 0.f, 0.f};
                unsigned doff[6]; unsigned dz = 0u;
#pragma unroll
                for (int j = 0; j < 6; ++j) {
                    const int pc = wave + 8 * j;
                    if (pc < 28) { const int off = pc * 1024 + lane * 16, row = off / S96, col = off - row * S96;
                        if (col >= 128 && col < 192) { doff[j] = (unsigned)(row * (ZLD * 2) + (col - 128)); dz |= 1u << j; }
                        else doff[j] = (unsigned)(row * 1024 + (col < 128 ? col : 0)); }
                    else { const int off = (pc - 28) * 1024 + lane * 16, row = off / S64, col = off - row * S64;
                        doff[j] = (unsigned)(row * 1024 + 128 + (col < 128 ? col : 0)); }
                }
                auto dma = [&](int c, int buf) {
                    const size_t key0 = tb + (size_t)c * 128;
                    const char* kvb = (const char*)(KVB + key0 * 512 + 128 * h);
                    const char* zkr = (const char*)(Z + key0 * ZLD + ZC_KR);
#pragma unroll
                    for (int j = 0; j < 6; ++j) {
                        const int pc = wave + 8 * j;
                        const char* src = (((dz >> j) & 1u) ? zkr : kvb) + doff[j];
                        __builtin_amdgcn_global_load_lds((const unsigned*)src, (LAS unsigned*)(lds + buf * BUF_BYTES + pc * 1024), 16, 0, 0);
                    }
                };
                constexpr float THR = 8.0f;
                bf16x8 kf[6]; f32x4 s0[2], s1[2], negm[2], lacc[2];
                const bf16x8 ones = {0x3f80, 0x3f80, 0x3f80, 0x3f80, 0x3f80, 0x3f80, 0x3f80, 0x3f80};
#pragma unroll
                for (int t = 0; t < 2; ++t) { negm[t] = (f32x4){0.f, 0.f, 0.f, 0.f}; lacc[t] = (f32x4){0.f, 0.f, 0.f, 0.f}; }
                auto kload = [&](LAS const unsigned char* Kl, int kb) {
                    LAS const unsigned char* kp = Kl + (kb + i) * S96 + g4 * 16;
#pragma unroll
                    for (int ks = 0; ks < 3; ++ks) { kf[2 * ks] = *(LAS const bf16x8*)(kp + ks * 64); kf[2 * ks + 1] = *(LAS const bf16x8*)(kp + 16 * S96 + ks * 64); }
                };
                auto qkm = [&]() {
#pragma unroll
                    for (int t = 0; t < 2; ++t) {
                        s0[t] = __builtin_amdgcn_mfma_f32_16x16x32_bf16(kf[0], qf[t][0], negm[t], 0, 0, 0);
                        s1[t] = __builtin_amdgcn_mfma_f32_16x16x32_bf16(kf[1], qf[t][0], negm[t], 0, 0, 0);
                    }
#pragma unroll
                    for (int ks = 1; ks < 3; ++ks)
#pragma unroll
                        for (int t = 0; t < 2; ++t) {
                            s0[t] = __builtin_amdgcn_mfma_f32_16x16x32_bf16(kf[2 * ks], qf[t][ks], s0[t], 0, 0, 0);
                            s1[t] = __builtin_amdgcn_mfma_f32_16x16x32_bf16(kf[2 * ks + 1], qf[t][ks], s1[t], 0, 0, 0);
                        }
                };
                auto smpv = [&](LAS const unsigned char* vp) {
                    bf16x8 pb[2];
#pragma unroll
                    for (int t = 0; t < 2; ++t) {
                        float mx = __builtin_fmaxf(__builtin_fmaxf(s0[t][0], s0[t][1]), s0[t][2]);
                        mx = __builtin_fmaxf(__builtin_fmaxf(mx, s0[t][3]), s1[t][0]);
                        mx = __builtin_fmaxf(__builtin_fmaxf(mx, s1[t][1]), s1[t][2]);
                        mx = __builtin_fmaxf(mx, s1[t][3]);
                        if (__any(mx > THR)) {
                            mx = fmaxf(mx, __shfl_xor(mx, 16)); mx = fmaxf(mx, __shfl_xor(mx, 32));
                            const float dl = fmaxf(mx, 0.f);
                            const float alpha = __builtin_amdgcn_exp2f(-dl);
                            negm[t] = negm[t] - dl;
                            lacc[t] = lacc[t] * alpha;
#pragma unroll
                            for (int db = 0; db < 4; ++db) o[t][db] = o[t][db] * alpha;
                            s0[t] = s0[t] - dl; s1[t] = s1[t] - dl;
                        }
                        u32x4 w;
                        w.x = pk2(__builtin_amdgcn_exp2f(s0[t][0]), __builtin_amdgcn_exp2f(s0[t][1])); w.y = pk2(__builtin_amdgcn_exp2f(s0[t][2]), __builtin_amdgcn_exp2f(s0[t][3]));
                        w.z = pk2(__builtin_amdgcn_exp2f(s1[t][0]), __builtin_amdgcn_exp2f(s1[t][1])); w.w = pk2(__builtin_amdgcn_exp2f(s1[t][2]), __builtin_amdgcn_exp2f(s1[t][3]));
                        pb[t] = __builtin_bit_cast(bf16x8, w);
                    }
#pragma unroll
                    for (int t = 0; t < 2; ++t) lacc[t] = __builtin_amdgcn_mfma_f32_16x16x32_bf16(ones, pb[t], lacc[t], 0, 0, 0);
#pragma unroll
                    for (int db = 0; db < 4; ++db) {
                        const s16x4 lo = vtr(vp + db * 32), hi = vtr(vp + 16 * S64 + db * 32);
                        const bf16x8 va = {lo[0], lo[1], lo[2], lo[3], hi[0], hi[1], hi[2], hi[3]};
#pragma unroll
                        for (int t = 0; t < 2; ++t) o[t][db] = __builtin_amdgcn_mfma_f32_16x16x32_bf16(va, pb[t], o[t][db], 0, 0, 0);
                    }
                };
#define MLA_VP(VL, KBV) ((VL) + ((KBV) + 4 * g4 + (i >> 2)) * S64 + (i & 3) * 8)
#define MLA_STEP(KLN, KBN, VL, KBV) do { kload(KLN, KBN); __builtin_amdgcn_sched_barrier(0); smpv(MLA_VP(VL, KBV)); qkm(); __builtin_amdgcn_sched_barrier(0); } while (0)
                dma(0, 0); dma(1, 1);
                asm volatile("s_waitcnt vmcnt(0)" ::: "memory"); __syncthreads();
                kload(lds, 0); qkm();
                int bc = 0;
                for (int c = 0; c < 32; ++c) {
                    const int bn = (bc == 2) ? 0 : bc + 1, bp = (bc == 0) ? 2 : bc - 1;
                    LAS const unsigned char* Kl = lds + bc * BUF_BYTES; LAS const unsigned char* Vl = Kl + KB_BYTES;
                    MLA_STEP(Kl, 32, Vl, 0);
                    MLA_STEP(Kl, 64, Vl, 32);
                    MLA_STEP(Kl, 96, Vl, 64);
                    asm volatile("s_waitcnt vmcnt(0)" ::: "memory");
                    __syncthreads();
                    if (c + 2 < 32) dma(c + 2, bp);
                    if (c + 1 < 32) { MLA_STEP(lds + bn * BUF_BYTES, 0, Vl, 96); }
                    else { smpv(MLA_VP(Vl, 96)); }
                    bc = bn;
                }
#undef MLA_STEP
#undef MLA_VP
                __syncthreads();
#pragma unroll
                for (int t = 0; t < 2; ++t) {
                    const float inv = 1.0f / lacc[t][0];
                    bf16_t* op = OB + (tb + qb * 256 + 32 * wave + 16 * t + i) * DM + 768 + 64 * h + 4 * g4;
#pragma unroll
                    for (int db = 0; db < 4; ++db) { u32x2 w; w.x = pk2(o[t][db][0] * inv, o[t][db][1] * inv); w.y = pk2(o[t][db][2] * inv, o[t][db][3] * inv); *(u32x2*)(op + 16 * db) = w; }
                }
            }
        }
        {
            LOCAL_IDS
            LAS unsigned char* Kl = lds; LAS unsigned char* Vl = lds + 2 * 128 * S64; LAS float* lutl = (LAS float*)(lds + 4 * 128 * S64);
            const int i = lane & 15, g4 = lane >> 4, hh = wave >> 2, ct = wave & 3;
            const int cbase = ct == 0 ? 0 : (ct == 1 ? 8 : (ct == 2 ? 24 : 32));
            const float* rpb = P.in[I_RPB] + (size_t)l * 4 * 465;
            for (int e = tid; e < 1860; e += NTHR) lutl[e] = rpb[e] * LOG2E;
            int bid2 = bid; asm volatile("" : "+s"(bid2));
            const int per = (2048 + G - 1) / G, u0 = min(bid2 * per, 2047), u1 = min(bid2 * per + per, 2048), nf = (u1 - u0) * 4;
            const int qc = 16 * ct + i, cs = min(max(qc - 8, 0), 48);
            u32x4 pk[4], pvv[4], pq[2];
            auto issue = [&](int f) {
                const int unit = u0 + (f >> 2), c = f & 3, b = unit >> 7, rr = (unit >> 1) & 63, hp = unit & 1;
                const int r0 = min(max(rr - 4, 0), 56), tk0 = (r0 + 2 * c) * 64;
                const bf16_t* zb = Z + (size_t)b * SEQ * ZLD;
#pragma unroll
                for (int it = 0; it < 4; ++it) {
                    const int e = tid + NTHR * it, h2 = e >> 10, row = (e >> 3) & 127, ch = e & 7;
                    const bf16_t* src = zb + (size_t)(tk0 + row) * ZLD + 64 * (2 * hp + h2) + 8 * ch;
                    pk[it] = *(const u32x4*)(src + ZC_KA); pvv[it] = *(const u32x4*)(src + ZC_VA);
                }
                if (c == 0) { const bf16_t* qp = zb + (size_t)(rr * 64 + qc) * ZLD + ZC_QA + 64 * (2 * hp + hh) + 8 * g4; pq[0] = *(const u32x4*)qp; pq[1] = *(const u32x4*)(qp + 32); }
            };
            auto commit = [&]() {
#pragma unroll
                for (int it = 0; it < 4; ++it) { const int e = tid + NTHR * it, h2 = e >> 10, row = (e >> 3) & 127, ch = e & 7;
                    *(LAS u32x4*)(Kl + (h2 * 128 + row) * S64 + ch * 16) = pk[it]; *(LAS u32x4*)(Vl + (h2 * 128 + row) * S64 + ch * 16) = pvv[it]; }
            };
            bf16x8 qf[1][2]; f32x4 o[1][4]; float mr[1] = {0.f}, lr[1] = {0.f};
            qf[0][0] = (bf16x8){0, 0, 0, 0, 0, 0, 0, 0}; qf[0][1] = qf[0][0];
#pragma unroll
            for (int db = 0; db < 4; ++db) o[0][db] = (f32x4){0.f, 0.f, 0.f, 0.f};
            issue(0);
            for (int f = 0; f < nf; ++f) {
                const int unit = u0 + (f >> 2), c = f & 3, b = unit >> 7, rr = (unit >> 1) & 63, hp = unit & 1, head = 2 * hp + hh;
                const int r0 = min(max(rr - 4, 0), 56);
                commit();
                if (c == 0) {
                    qf[0][0] = __builtin_bit_cast(bf16x8, scale_bf8(pq[0], 0.125f * LOG2E)); qf[0][1] = __builtin_bit_cast(bf16x8, scale_bf8(pq[1], 0.125f * LOG2E));
                    mr[0] = 0.f; lr[0] = 0.f;
#pragma unroll
                    for (int db = 0; db < 4; ++db) o[0][db] = (f32x4){0.f, 0.f, 0.f, 0.f};
                }
                __syncthreads();
                if (f + 1 < nf) issue(f + 1);
#pragma unroll
                for (int kr = 0; kr < 2; ++kr) {
                    const int dr = (r0 + 2 * c + kr) - rr + 7;
                    const LAS float* lrow = lutl + head * 465 + dr * 31;
                    auto bm = [&](f32x4& s0, f32x4& s1, int, int) {
#pragma unroll
                        for (int j = 0; j < 4; ++j) {
                            { const int kc = cbase + 4 * g4 + j; const bool ok = (kc >= cs) && (kc < cs + 16); const int idx = min(max(kc - qc + 15, 0), 30);
                              s0[j] = ok ? s0[j] + lrow[idx] : -INFINITY; }
                            { const int kc = cbase + 16 + 4 * g4 + j; const bool ok = (kc >= cs) && (kc < cs + 16); const int idx = min(max(kc - qc + 15, 0), 30);
                              s1[j] = ok ? s1[j] + lrow[idx] : -INFINITY; }
                        }
                    };
                    attn_step<2, 1, S64>(Kl + hh * 128 * S64, Vl + hh * 128 * S64, kr * 64 + cbase, qf, o, mr, lr, lane, bm);
                }
                if (c == 3) {
                    float lt = lr[0]; lt += __shfl_xor(lt, 16); lt += __shfl_xor(lt, 32);
                    const float inv = 1.0f / lt;
                    bf16_t* op = OB + ((size_t)b * SEQ + rr * 64 + qc) * DM + 64 * head + 4 * g4;
#pragma unroll
                    for (int db = 0; db < 4; ++db) { u32x2 w; w.x = pk2(o[0][db][0] * inv, o[0][db][1] * inv); w.y = pk2(o[0][db][2] * inv, o[0][db][3] * inv); *(u32x2*)(op + 16 * db) = w; }
                }
                __syncthreads();
            }
        }
        { LOCAL_IDS
        const int h = lane >> 3;
        for (int row0 = gw; row0 < MTOK; row0 += 4 * NGW) {
            u32x4 pa[4], pb_[4], pc[4]; float l0[4], l1[4], l2[4];
#pragma unroll
            for (int r = 0; r < 4; ++r) { const size_t row = (size_t)(row0 + r * NGW);
                l0[r] = lse[((size_t)0 * MTOK + row) * 8 + h]; l1[r] = lse[((size_t)1 * MTOK + row) * 8 + h]; l2[r] = lse[((size_t)2 * MTOK + row) * 8 + h];
                pa[r] = *(const u32x4*)(PART + ((size_t)0 * MTOK + row) * 512 + 8 * lane);
                pb_[r] = *(const u32x4*)(PART + ((size_t)1 * MTOK + row) * 512 + 8 * lane);
                pc[r] = *(const u32x4*)(PART + ((size_t)2 * MTOK + row) * 512 + 8 * lane); }
#pragma unroll
            for (int r = 0; r < 4; ++r) {
                const float mx = fmaxf(l0[r], fmaxf(l1[r], l2[r]));
                float w0 = __builtin_amdgcn_exp2f(l0[r] - mx), w1 = __builtin_amdgcn_exp2f(l1[r] - mx), w2 = __builtin_amdgcn_exp2f(l2[r] - mx);
                const float inv = 1.0f / (w0 + w1 + w2); w0 *= inv; w1 *= inv; w2 *= inv;
                const u32x4 a = pa[r], bq = pb_[r], cq = pc[r];
                u32x4 o;
                o.x = pk2(w0 * bflo(a.x) + w1 * bflo(bq.x) + w2 * bflo(cq.x), w0 * bfhi(a.x) + w1 * bfhi(bq.x) + w2 * bfhi(cq.x));
                o.y = pk2(w0 * bflo(a.y) + w1 * bflo(bq.y) + w2 * bflo(cq.y), w0 * bfhi(a.y) + w1 * bfhi(bq.y) + w2 * bfhi(cq.y));
                o.z = pk2(w0 * bflo(a.z) + w1 * bflo(bq.z) + w2 * bflo(cq.z), w0 * bfhi(a.z) + w1 * bfhi(bq.z) + w2 * bfhi(cq.z));
                o.w = pk2(w0 * bflo(a.w) + w1 * bflo(bq.w) + w2 * bflo(cq.w), w0 * bfhi(a.w) + w1 * bfhi(bq.w) + w2 * bfhi(cq.w));
                *(u32x4*)(OB + (size_t)(row0 + r * NGW) * DM + 256 + 8 * lane) = o;
            }
        } }
        GSYNC();
        {
            pg8::Gemm g{OB, (const bf16_t*)(wl + WL_OUT), MTOK, DM, DM, DM}; pg8::StaticOrder S; S.init(MTOK, DM, G, bid);
            float* xs = (float*)(ws + WS_XSLOT); unsigned* xc = (unsigned*)(ws + WS_XCNT); const int q0 = (l * 2 + 0) * 2;
            pg8::EpiNorm E{(l == 0 ? P.in[I_X] : P.out), P.out, XN, P.in[I_GPOSTMIX] + l * DM, P.in[I_GPREFFN] + l * DM, modl, 2048, 4096, 3072,
                           xs + (size_t)q0 * MTOK * 4, xc + (size_t)q0 * 256 * 64, xs + (size_t)(q0 + 1) * MTOK * 4, xc + (size_t)(q0 + 1) * 256 * 64, lds + 131072};
            pg8::gemm_phase(lds, g, S, E, wave_s);
        }
        GSYNC();
        {
            pg8::Gemm g{XN, (const bf16_t*)(wl + WL_UP) + (size_t)DFF * DM, MTOK, DFF, DM, DM}; pg8::StaticOrder S; S.init(MTOK, DFF, G, bid);
            pg8::EpiStore16 E{GB, DFF};
            pg8::gemm_phase(lds, g, S, E, wave_s);
        }
        GSYNC();
        {
            pg8::Gemm g{XN, (const bf16_t*)(wl + WL_UP), MTOK, DFF, DM, DM}; pg8::StaticOrder S; S.init(MTOK, DFF, G, bid);
            pg8::EpiGate E{HID, GB, P.in[I_CONVW] + (size_t)l * 3 * DFF, P.in[I_CONVB] + (size_t)l * DFF};
            pg8::gemm_phase(lds, g, S, E, wave_s);
        }
        GSYNC();
        {
            pg8::Gemm g{HID, (const bf16_t*)(wl + WL_DOWN), MTOK, DM, DFF, DFF}; pg8::StaticOrder S; S.init(MTOK, DM, G, bid);
            float* xs = (float*)(ws + WS_XSLOT); unsigned* xc = (unsigned*)(ws + WS_XCNT); const int q0 = (l * 2 + 1) * 2;
            const int ln = (l + 1 < DEPTH) ? l + 1 : l;
            pg8::EpiNorm E{P.out, P.out, (l + 1 < DEPTH) ? XN : nullptr, P.in[I_GPOSTFFN] + l * DM, P.in[I_GPREMIX] + ln * DM, modl, 5120, (ln - l) * 16 * 6144 + 1024, (ln - l) * 16 * 6144,
                           xs + (size_t)q0 * MTOK * 4, xc + (size_t)q0 * 256 * 64, xs + (size_t)(q0 + 1) * MTOK * 4, xc + (size_t)(q0 + 1) * 256 * 64, lds + 131072};
            pg8::gemm_phase(lds, g, S, E, wave_s);
        }
        if (l + 1 < DEPTH) GSYNC();
    }
}

extern "C" void kernel_launch(void* const* d_in, const int* in_sizes, int n_in, void* d_out, int out_size, void* d_ws, size_t ws_size, hipStream_t stream) {
    static int grid_blocks = 0;
    if (grid_blocks == 0) {
        if (n_in != 20 || ws_size < WS_END) { fprintf(stderr, "kernel_launch: unexpected n_in %d or ws_size %zu\n", n_in, ws_size); grid_blocks = -1; return; }
        int dev = 0, cus = 0, per_cu = 0;
        hipGetDevice(&dev);
        hipDeviceGetAttribute(&cus, hipDeviceAttributeMultiprocessorCount, dev);
        if (hipFuncSetAttribute((const void*)fwd_megakernel, hipFuncAttributeMaxDynamicSharedMemorySize, LDS_BYTES) != hipSuccess) fprintf(stderr, "kernel_launch: hipFuncSetAttribute failed\n");
        hipOccupancyMaxActiveBlocksPerMultiprocessor(&per_cu, (const void*)fwd_megakernel, NTHR, LDS_BYTES);
        (void)hipGetLastError();
        if (per_cu < 1) { fprintf(stderr, "kernel_launch: occupancy query gives %d\n", per_cu); per_cu = 1; }
        grid_blocks = 256;
        if (cus < 256) fprintf(stderr, "kernel_launch: device has %d CUs, this kernel needs 256\n", cus);
    }
    if (grid_blocks < 0) return;
    Params p{};
    for (int i = 0; i < 20; ++i) p.in[i] = (const float*)d_in[i];
    p.out = (float*)d_out; p.ws = (unsigned char*)d_ws;
    void* args[] = {&p};
    hipError_t e = hipLaunchCooperativeKernel((const void*)fwd_megakernel, dim3(grid_blocks), dim3(NTHR), args, LDS_BYTES, stream);
    if (e != hipSuccess) fprintf(stderr, "cooperative launch failed: %s (grid %d)\n", hipGetErrorString(e), grid_blocks);
}
```

```cpp
#include <hip/hip_runtime.h>
#include <hip/hip_cooperative_groups.h>
#include <cstdint>
#include <cstdio>
namespace cg = cooperative_groups;

#define LAS __attribute__((address_space(3)))
typedef unsigned short bf16_t;
typedef short bf16x8 __attribute__((ext_vector_type(8)));
typedef short s16x4 __attribute__((ext_vector_type(4)));
typedef float f32x4 __attribute__((ext_vector_type(4)));
typedef float f32x2 __attribute__((ext_vector_type(2)));
typedef unsigned u32x4 __attribute__((ext_vector_type(4)));
typedef unsigned u32x2 __attribute__((ext_vector_type(2)));
typedef __bf16 bf16x2_t __attribute__((ext_vector_type(2)));

constexpr int DM = 1024, NB = 16, SEQ = 4096, MTOK = NB * SEQ, DEPTH = 4;
constexpr int DIN = 2976, ZLD = 3072, DFF = 2816;
constexpr int ZC_QA = 0, ZC_KA = 256, ZC_VA = 512, ZC_QB = 768, ZC_KB = 1280, ZC_VB = 1792, ZC_CQ = 2304, ZC_CKV = 2688, ZC_KR = 2944;
constexpr float EPS = 1e-6f, LOG2E = 1.4426950408889634f;
constexpr int NTHR = 512, NWAVE = 8;
constexpr int S64 = 160, S96 = 224;

constexpr size_t MiB = 1u << 20;
constexpr size_t WS_MOD = 0;
constexpr size_t WS_BAR = MiB + 768 * 1024;
constexpr size_t WS_ROPE = 2 * MiB;
constexpr size_t WS_RQ = 3 * MiB;
constexpr size_t WS_LUT = 3 * MiB + 512 * 1024;
constexpr size_t WS_LSE = 4 * MiB;
constexpr size_t WS_W = 16 * MiB;
constexpr size_t WL_STRIDE = 26 * MiB;
constexpr size_t WL_IN = 0, WL_OUT = 6 * MiB, WL_UP = 8 * MiB, WL_DOWN = 19 * MiB, WL_UQ = 24 * MiB + 512 * 1024, WL_UKV = 25 * MiB;
constexpr size_t WS_XN = 120 * MiB;
constexpr size_t WS_Z = 248 * MiB;
constexpr size_t WS_Q = 632 * MiB;
constexpr size_t WS_KV = 680 * MiB;
constexpr size_t WS_PART = 744 * MiB;
constexpr size_t WS_G = 248 * MiB;
constexpr size_t WS_HID = 600 * MiB;
constexpr size_t WS_XSLOT = 952 * MiB;
constexpr size_t WS_XCNT = 968 * MiB;
constexpr size_t WS_END = 969 * MiB;

__device__ __forceinline__ unsigned pk2(float lo, float hi) { f32x2 v = {lo, hi}; bf16x2_t b = __builtin_convertvector(v, bf16x2_t); return __builtin_bit_cast(unsigned, b); }
__device__ __forceinline__ float bflo(unsigned u) { return __uint_as_float(u << 16); }
__device__ __forceinline__ float bfhi(unsigned u) { return __uint_as_float(u & 0xffff0000u); }
__device__ __forceinline__ int flat_tid(int wave_s) { unsigned z = 0u; asm volatile("" : "+v"(z));
    return wave_s * 64 + (int)__builtin_amdgcn_mbcnt_hi(~0u, __builtin_amdgcn_mbcnt_lo(~0u, z)); }
__device__ __forceinline__ float wave_sum(float v) {
#pragma unroll
    for (int o = 1; o < 64; o <<= 1) v += __shfl_xor(v, o);
    return v;
}
__device__ __forceinline__ u32x4 scale_bf8(u32x4 v, float s) {
    u32x4 r;
    r.x = pk2(bflo(v.x) * s, bfhi(v.x) * s); r.y = pk2(bflo(v.y) * s, bfhi(v.y) * s);
    r.z = pk2(bflo(v.z) * s, bfhi(v.z) * s); r.w = pk2(bflo(v.w) * s, bfhi(v.w) * s);
    return r;
}

namespace pg8 {
constexpr int BM = 256, BK = 64, HALF = 128, HTB = HALF * BK * 2, STAGE_BYTES = 8 * HTB, NXCD = 8, WGM = 8;
__device__ __forceinline__ int lds_byte(int r, int c) { const int st = (r >> 4) * 2 + (c >> 5), rr = r & 15, cc = c & 31, ob = rr * 64 + cc * 2; return st * 1024 + (ob ^ (((ob >> 9) & 1) << 5)); }
__device__ __forceinline__ void stage_rc(int b, int& R, int& C) { const int st = b / 1024, sb = b % 1024, swz = sb ^ (((sb >> 9) & 1) << 5); R = (st >> 1) * 16 + swz / 64; C = (st & 1) * 32 + (swz % 64) / 2; }

__device__ __forceinline__ int perm32(int rho) { const int n = rho >> 4, i = rho & 15; return 8 * (i >> 2) + 4 * n + (i & 3); }
struct Unit { int pm, pn; };
struct Gemm { const bf16_t* A; const bf16_t* Bt; int M, N, K, lda; };

struct StaticOrder {
    int nM, nN, nwg, G, c;
    __device__ void init(int M, int N, int G_, int c_) { nM = M / BM; nN = N / BM; nwg = nM * nN; G = G_; c = c_; }
    __device__ bool next(int i, Unit& u) const {
        const long L = (long)i * G + c; if (L >= nwg) return false;
        int wgid = (int)L; { const int q = nwg / NXCD, r = nwg % NXCD, xcd = wgid % NXCD, off = wgid / NXCD; wgid = (xcd < r ? xcd * (q + 1) : r * (q + 1) + (xcd - r) * q) + off; }
        const int nig = WGM * nN, gid = wgid / nig, fm = gid * WGM, gsz = (nM - fm) < WGM ? (nM - fm) : WGM;
        u.pm = fm + ((wgid % nig) % gsz); u.pn = (wgid % nig) / gsz; return true;
    }
};

template <class Epi>
__device__ __forceinline__ void gemm_phase(LAS unsigned char* lds, const Gemm g, const StaticOrder& S, const Epi& E, int wave_s) {
    int tid = flat_tid(wave_s); asm volatile("" : "+v"(tid));
    const int wid = __builtin_amdgcn_readfirstlane(tid >> 6), lane = tid & 63, wr = wid >> 2, wc = wid & 3, fr = lane & 15, fq = lane >> 4;
    const int K = g.K, nt = K / BK, lda = g.lda;
    unsigned voffA[2], voffB[2];
#pragma unroll
    for (int i = 0; i < 2; ++i) { int R, C; stage_rc(tid * 16 + i * 8192, R, C);
        const int Rb = Epi::PERM ? ((R & ~31) + perm32(R & 31)) : R;
        voffA[i] = (unsigned)(R * lda + C) * 2u; voffB[i] = (unsigned)(Rb * K + C) * 2u; }
    const size_t kstep = (size_t)(BK * 2);
    const size_t hstepA = (size_t)HALF * lda * 2, hstepB = (size_t)HALF * K * 2;
    const size_t tstepA = 2 * hstepA, tstepB = 2 * hstepB;
    const unsigned ldsw = (unsigned)wid * 1024u;
    const int aoff = lds_byte(wr * 64 + fr, fq * 8), boff = lds_byte(wc * 32 + fr, fq * 8);
#define PG8_SA(b, h) (((b) * 2 + (h)) * HTB)
#define PG8_SB(b, h) ((4 + (b) * 2 + (h)) * HTB)
#define PG8_STAGE(bufoff, gbase, voff) do { _Pragma("unroll") for (int _i = 0; _i < 2; ++_i) \
        __builtin_amdgcn_global_load_lds((const unsigned*)((const char*)(gbase) + (voff)[_i]), (LAS unsigned*)(lds + (bufoff) + ldsw + _i * 8192), 16, 0, 0); } while (0)
#define PG8_LDA(dst, b, h) do { _Pragma("unroll") for (int m = 0; m < 4; ++m) _Pragma("unroll") for (int k = 0; k < 2; ++k) dst[m][k] = *(const LAS bf16x8*)(lds + PG8_SA(b, h) + aoff + m * 2048 + k * 1024); } while (0)
#define PG8_LDB(dst, b, h) do { _Pragma("unroll") for (int n = 0; n < 2; ++n) _Pragma("unroll") for (int k = 0; k < 2; ++k) dst[n][k] = *(const LAS bf16x8*)(lds + PG8_SB(b, h) + boff + n * 2048 + k * 1024); } while (0)
#define PG8_MMA(ai, bj, At, Bt) do { __builtin_amdgcn_s_setprio(1); _Pragma("unroll") for (int m = 0; m < 4; ++m) _Pragma("unroll") for (int n = 0; n < 2; ++n) _Pragma("unroll") for (int k = 0; k < 2; ++k) \
        acc[ai][bj][m][n] = __builtin_amdgcn_mfma_f32_16x16x32_bf16(Bt[n][k], At[m][k], acc[ai][bj][m][n], 0, 0, 0); __builtin_amdgcn_s_setprio(0); } while (0)
#define PG8_WAIT_V(n) asm volatile("s_waitcnt vmcnt(" #n ")" ::: "memory")
#define PG8_WAIT_L(n) asm volatile("s_waitcnt lgkmcnt(" #n ")" ::: "memory")
#define PG8_BAR __builtin_amdgcn_s_barrier()
#define PG8_SCHED __builtin_amdgcn_sched_barrier(0)
    Unit cur, nxt; int ui = 0;
    if (!S.next(0, cur)) return;
    f32x4 acc[2][2][4][2];
#pragma unroll
    for (int a = 0; a < 2; ++a)
#pragma unroll
        for (int b = 0; b < 2; ++b)
#pragma unroll
            for (int m = 0; m < 4; ++m)
#pragma unroll
                for (int n = 0; n < 2; ++n) acc[a][b][m][n] = (f32x4){0.f, 0.f, 0.f, 0.f};
    bf16x8 At[4][2], B0[2][2], B1[2][2];
    const char* cA = (const char*)g.A + (size_t)cur.pm * tstepA; const char* cB = (const char*)g.Bt + (size_t)cur.pn * tstepB;
    PG8_STAGE(PG8_SB(0, 0), cB, voffB); PG8_STAGE(PG8_SB(0, 1), cB + hstepB, voffB); PG8_STAGE(PG8_SA(0, 0), cA, voffA); PG8_STAGE(PG8_SA(0, 1), cA + hstepA, voffA);
    if (wr == 1) PG8_BAR;
    PG8_WAIT_V(2); PG8_BAR;
    PG8_STAGE(PG8_SB(1, 0), cB + kstep, voffB); PG8_STAGE(PG8_SA(1, 0), cA + kstep, voffA); PG8_STAGE(PG8_SB(1, 1), cB + hstepB + kstep, voffB);
    PG8_WAIT_V(6); PG8_BAR;
    for (;;) {
        const bool has_next = S.next(ui + 1, nxt);
        const char* nA = has_next ? (const char*)g.A + (size_t)nxt.pm * tstepA : cA; const char* nB = has_next ? (const char*)g.Bt + (size_t)nxt.pn * tstepB : cB;
        for (int t = 0; t < nt; t += 2) {
            const bool last = (t == nt - 2);
            const char* a1 = cA + (size_t)(t + 1) * kstep;
            const char* a2 = last ? nA : cA + (size_t)(t + 2) * kstep; const char* b2 = last ? nB : cB + (size_t)(t + 2) * kstep;
            const char* a3 = a2 + kstep; const char* b3 = b2 + kstep;
            PG8_LDB(B0, 0, 0); PG8_LDB(B1, 0, 1); PG8_SCHED; PG8_LDA(At, 0, 0); PG8_STAGE(PG8_SA(1, 1), a1 + hstepA, voffA);
            PG8_WAIT_V(8); PG8_WAIT_L(0); PG8_BAR; PG8_MMA(0, 0, At, B0); PG8_MMA(0, 1, At, B1); PG8_BAR; PG8_SCHED;
            PG8_LDA(At, 0, 1); PG8_STAGE(PG8_SB(0, 0), b2, voffB); PG8_STAGE(PG8_SB(0, 1), b2 + hstepB, voffB); PG8_STAGE(PG8_SA(0, 0), a2, voffA);
            PG8_WAIT_V(8); PG8_WAIT_L(0); PG8_BAR; PG8_MMA(1, 0, At, B0); PG8_MMA(1, 1, At, B1); PG8_BAR; PG8_SCHED;
            PG8_LDB(B0, 1, 0); PG8_LDB(B1, 1, 1); PG8_SCHED; PG8_LDA(At, 1, 0); PG8_STAGE(PG8_SA(0, 1), a2 + hstepA, voffA);
            PG8_WAIT_V(8); PG8_WAIT_L(0); PG8_BAR; PG8_MMA(0, 0, At, B0); PG8_MMA(0, 1, At, B1); PG8_BAR; PG8_SCHED;
            PG8_LDA(At, 1, 1); PG8_STAGE(PG8_SB(1, 0), b3, voffB); PG8_STAGE(PG8_SB(1, 1), b3 + hstepB, voffB); PG8_STAGE(PG8_SA(1, 0), a3, voffA);
            PG8_WAIT_V(8); PG8_WAIT_L(0); PG8_BAR; PG8_MMA(1, 0, At, B0); PG8_MMA(1, 1, At, B1); PG8_BAR; PG8_SCHED;
        }
        if (wr == 0) PG8_BAR;
        E(acc, cur, wr, wc, fr, fq);
        if (!has_next) break;
#pragma unroll
        for (int a = 0; a < 2; ++a)
#pragma unroll
            for (int b = 0; b < 2; ++b)
#pragma unroll
                for (int m = 0; m < 4; ++m)
#pragma unroll
                    for (int n = 0; n < 2; ++n) acc[a][b][m][n] = (f32x4){0.f, 0.f, 0.f, 0.f};
        cur = nxt; cA = nA; cB = nB; ++ui;
        if (wr == 1) PG8_BAR;
    }
    PG8_WAIT_V(0);
    PG8_BAR;
#undef PG8_SA
#undef PG8_SB
#undef PG8_STAGE
#undef PG8_LDA
#undef PG8_LDB
#undef PG8_MMA
#undef PG8_WAIT_V
#undef PG8_WAIT_L
#undef PG8_BAR
#undef PG8_SCHED
}

struct EpiStore16 {
    static constexpr bool PERM = true;
    bf16_t* O; int ldc;
    __device__ __forceinline__ void operator()(const f32x4 (&acc)[2][2][4][2], const Unit& u, int wr, int wc, int fr, int fq) const {
#pragma unroll
        for (int ai = 0; ai < 2; ++ai)
#pragma unroll
            for (int m = 0; m < 4; ++m) {
                bf16_t* rowp = O + (size_t)(u.pm * BM + ai * HALF + wr * 64 + m * 16 + fr) * ldc + u.pn * BM + wc * 32 + 8 * fq;
#pragma unroll
                for (int bj = 0; bj < 2; ++bj) { const f32x4 v0 = acc[ai][bj][m][0], v1 = acc[ai][bj][m][1];
                    u32x4 w; w.x = pk2(v0[0], v0[1]); w.y = pk2(v0[2], v0[3]); w.z = pk2(v1[0], v1[1]); w.w = pk2(v1[2], v1[3]);
                    *(u32x4*)(rowp + bj * HALF) = w; }
            }
    }
};
struct EpiStoreKV {
    static constexpr bool PERM = true;
    bf16_t* O; int ldc; const bf16_t* Zc;
    __device__ __forceinline__ void operator()(const f32x4 (&acc)[2][2][4][2], const Unit& u, int wr, int wc, int fr, int fq) const {
#pragma unroll
        for (int ai = 0; ai < 2; ++ai)
#pragma unroll
            for (int m = 0; m < 4; ++m) {
                const int row = u.pm * BM + ai * HALF + wr * 64 + m * 16 + fr;
                const bf16_t* zr = Zc + (size_t)row * ZLD + 64 * fq;
                float ss = 0.f;
#pragma unroll
                for (int c = 0; c < 8; ++c) { const u32x4 v = *(const u32x4*)(zr + 8 * c);
                    ss += (bflo(v.x) * bflo(v.x) + bfhi(v.x) * bfhi(v.x)) + (bflo(v.y) * bflo(v.y) + bfhi(v.y) * bfhi(v.y)) + (bflo(v.z) * bflo(v.z) + bfhi(v.z) * bfhi(v.z)) + (bflo(v.w) * bflo(v.w) + bfhi(v.w) * bfhi(v.w)); }
                ss += __shfl_xor(ss, 16); ss += __shfl_xor(ss, 32);
                const float r = rsqrtf(ss * (1.0f / 256.0f) + EPS);
                bf16_t* rowp = O + (size_t)row * ldc + u.pn * BM + wc * 32 + 8 * fq;
#pragma unroll
                for (int bj = 0; bj < 2; ++bj) { const f32x4 v0 = acc[ai][bj][m][0] * r, v1 = acc[ai][bj][m][1] * r;
                    u32x4 w; w.x = pk2(v0[0], v0[1]); w.y = pk2(v0[2], v0[3]); w.z = pk2(v1[0], v1[1]); w.w = pk2(v1[2], v1[3]);
                    *(u32x4*)(rowp + bj * HALF) = w; }
            }
    }
};
struct EpiStore {
    static constexpr bool PERM = true;
    bf16_t* O; int ldc; int ncols; int rope_mode; const float* cosT; const float* sinT;
    __device__ __forceinline__ void operator()(const f32x4 (&acc)[2][2][4][2], const Unit& u, int wr, int wc, int fr, int fq) const {
#pragma unroll
        for (int bj = 0; bj < 2; ++bj) {
            const int cg0 = u.pn * BM + bj * HALF + wc * 32;
            if (cg0 >= ncols) continue;
            const bool rope = (rope_mode == 1) ? (cg0 == ZC_KR) : (rope_mode == 2 ? (((cg0 >> 5) % 3) == 2) : false);
#pragma unroll
            for (int ai = 0; ai < 2; ++ai)
#pragma unroll
                for (int m = 0; m < 4; ++m) {
                    const int row = u.pm * BM + ai * HALF + wr * 64 + m * 16 + fr;
                    f32x4 v0 = acc[ai][bj][m][0], v1 = acc[ai][bj][m][1];
                    if (rope) {
                        const int s = row & (SEQ - 1), ib = 8 * (fq & 1);
                        const f32x4 c0 = *(const f32x4*)(cosT + s * 16 + ib), c1 = *(const f32x4*)(cosT + s * 16 + ib + 4);
                        const f32x4 s0 = *(const f32x4*)(sinT + s * 16 + ib), s1 = *(const f32x4*)(sinT + s * 16 + ib + 4);
                        f32x4 p0, p1;
#pragma unroll
                        for (int e = 0; e < 4; ++e) { p0[e] = __shfl_xor(v0[e], 32); p1[e] = __shfl_xor(v1[e], 32); }
                        if (fq < 2) { v0 = v0 * c0 - p0 * s0; v1 = v1 * c1 - p1 * s1; }
                        else        { v0 = p0 * s0 + v0 * c0; v1 = p1 * s1 + v1 * c1; }
                    }
                    u32x4 w; w.x = pk2(v0[0], v0[1]); w.y = pk2(v0[2], v0[3]); w.z = pk2(v1[0], v1[1]); w.w = pk2(v1[2], v1[3]);
                    *(u32x4*)(O + (size_t)row * ldc + cg0 + 8 * fq) = w;
                }
        }
    }
};

struct EpiNorm {
    static constexpr bool PERM = true;
    const float* xin; float* xout; bf16_t* XN;
    const float* gpost; const float* gpre; const float* modb; int gate_off, sc_off, sh_off;
    float* slot1; unsigned* cnt1; float* slot2; unsigned* cnt2;
    LAS unsigned char* xl;
    __device__ __forceinline__ void rowstat(const f32x4 (&v)[2][2][4][2], const Unit& u, int wr, int wc, int fr, int fq, float* slot, unsigned* cnt) const {
        LAS float* Pp = (LAS float*)xl; LAS float* S = (LAS float*)(xl + 4096);
        const int wid = wr * 4 + wc, tid = wid * 64 + fq * 16 + fr;
#pragma unroll
        for (int ai = 0; ai < 2; ++ai)
#pragma unroll
            for (int m = 0; m < 4; ++m) {
                float ss = 0.f;
#pragma unroll
                for (int bj = 0; bj < 2; ++bj)
#pragma unroll
                    for (int n = 0; n < 2; ++n) { const f32x4 x = v[ai][bj][m][n]; ss += (x[0] * x[0] + x[1] * x[1]) + (x[2] * x[2] + x[3] * x[3]); }
                ss += __shfl_xor(ss, 16); ss += __shfl_xor(ss, 32);
                if (fq == 0) Pp[(ai * HALF + wr * 64 + m * 16 + fr) * 4 + wc] = ss;
            }
        asm volatile("s_waitcnt lgkmcnt(0)" ::: "memory"); __builtin_amdgcn_s_barrier(); asm volatile("" ::: "memory");
        if (tid < 256) {
            const float tot = (Pp[tid * 4 + 0] + Pp[tid * 4 + 1]) + (Pp[tid * 4 + 2] + Pp[tid * 4 + 3]);
            __hip_atomic_store(slot + ((size_t)u.pm * BM + tid) * 4 + u.pn, tot, __ATOMIC_RELAXED, __HIP_MEMORY_SCOPE_AGENT);
        }
        asm volatile("s_waitcnt vmcnt(0)" ::: "memory");
        if (wid < 4 && (tid & 63) == 0) __hip_atomic_fetch_add(cnt + 64 * u.pm, 1u, __ATOMIC_RELAXED, __HIP_MEMORY_SCOPE_AGENT);
        if (wid == 0) {
            unsigned sp = 0;
            while ((unsigned)__builtin_amdgcn_readfirstlane(__hip_atomic_load(cnt + 64 * u.pm, __ATOMIC_RELAXED, __HIP_MEMORY_SCOPE_AGENT)) < 16u) { __builtin_amdgcn_s_sleep(2); if (++sp > (1u << 20)) break; }
            __builtin_amdgcn_fence(__ATOMIC_ACQUIRE, "agent");
        }
        asm volatile("s_waitcnt vmcnt(0) lgkmcnt(0)" ::: "memory"); __builtin_amdgcn_s_barrier(); asm volatile("" ::: "memory");
        if (tid < 256) {
            const float* sp4 = slot + ((size_t)u.pm * BM + tid) * 4;
            const float t0 = __hip_atomic_load(sp4 + 0, __ATOMIC_RELAXED, __HIP_MEMORY_SCOPE_AGENT), t1 = __hip_atomic_load(sp4 + 1, __ATOMIC_RELAXED, __HIP_MEMORY_SCOPE_AGENT);
            const float t2 = __hip_atomic_load(sp4 + 2, __ATOMIC_RELAXED, __HIP_MEMORY_SCOPE_AGENT), t3 = __hip_atomic_load(sp4 + 3, __ATOMIC_RELAXED, __HIP_MEMORY_SCOPE_AGENT);
            S[tid] = rsqrtf(((t0 + t1) + (t2 + t3)) * (1.0f / DM) + EPS);
        }
        asm volatile("s_waitcnt vmcnt(0) lgkmcnt(0)" ::: "memory"); __builtin_amdgcn_s_barrier(); asm volatile("" ::: "memory");
    }
    __device__ __forceinline__ void operator()(f32x4 (&acc)[2][2][4][2], const Unit& u, int wr, int wc, int fr, int fq) const {
        const LAS float* S = (const LAS float*)(xl + 4096);
        const float* md = modb + (size_t)(u.pm >> 4) * 6144;
        rowstat(acc, u, wr, wc, fr, fq, slot1, cnt1);
#pragma unroll
        for (int bj = 0; bj < 2; ++bj)
#pragma unroll
            for (int n = 0; n < 2; ++n) {
                const int col = u.pn * BM + bj * HALF + wc * 32 + 8 * fq + 4 * n;
                const f32x4 gg = *(const f32x4*)(md + gate_off + col) * *(const f32x4*)(gpost + col);
#pragma unroll
                for (int ai = 0; ai < 2; ++ai)
#pragma unroll
                    for (int m = 0; m < 4; ++m) {
                        const int rl = ai * HALF + wr * 64 + m * 16 + fr; const size_t off = (size_t)(u.pm * BM + rl) * DM + col;
                        const f32x4 xv = *(const f32x4*)(xin + off);
                        const f32x4 xn = xv + gg * (acc[ai][bj][m][n] * S[rl]);
                        acc[ai][bj][m][n] = xn; *(f32x4*)(xout + off) = xn;
                    }
            }
        if (XN == nullptr) return;
        asm volatile("s_waitcnt lgkmcnt(0)" ::: "memory"); __builtin_amdgcn_s_barrier(); asm volatile("" ::: "memory");
        rowstat(acc, u, wr, wc, fr, fq, slot2, cnt2);
#pragma unroll
        for (int bj = 0; bj < 2; ++bj) {
            const int col = u.pn * BM + bj * HALF + wc * 32 + 8 * fq;
            f32x4 mp[2], sh[2];
#pragma unroll
            for (int n = 0; n < 2; ++n) { mp[n] = *(const f32x4*)(gpre + col + 4 * n) * (*(const f32x4*)(md + sc_off + col + 4 * n) + 1.0f); sh[n] = *(const f32x4*)(md + sh_off + col + 4 * n); }
#pragma unroll
            for (int ai = 0; ai < 2; ++ai)
#pragma unroll
                for (int m = 0; m < 4; ++m) {
                    const int rl = ai * HALF + wr * 64 + m * 16 + fr; const float r = S[rl];
                    const f32x4 h0 = (acc[ai][bj][m][0] * r) * mp[0] + sh[0], h1 = (acc[ai][bj][m][1] * r) * mp[1] + sh[1];
                    u32x4 w; w.x = pk2(h0[0], h0[1]); w.y = pk2(h0[2], h0[3]); w.z = pk2(h1[0], h1[1]); w.w = pk2(h1[2], h1[3]);
                    *(u32x4*)(XN + (size_t)(u.pm * BM + rl) * DM + col) = w;
                }
        }
        asm volatile("s_waitcnt lgkmcnt(0)" ::: "memory"); __builtin_amdgcn_s_barrier(); asm volatile("" ::: "memory");
    }
};

struct EpiGate {
    static constexpr bool PERM = true;
    bf16_t* H; const bf16_t* G; const float* cw; const float* cb;
    __device__ __forceinline__ void operator()(const f32x4 (&acc)[2][2][4][2], const Unit& u, int wr, int wc, int fr, int fq) const {
#pragma unroll
        for (int bj = 0; bj < 2; ++bj) {
            const int col = u.pn * BM + bj * HALF + wc * 32 + 8 * fq;
            f32x4 w0[2], w1[2], w2[2], bb[2];
#pragma unroll
            for (int n = 0; n < 2; ++n) { w0[n] = *(const f32x4*)(cw + col + 4 * n); w1[n] = *(const f32x4*)(cw + DFF + col + 4 * n); w2[n] = *(const f32x4*)(cw + 2 * DFF + col + 4 * n); bb[n] = *(const f32x4*)(cb + col + 4 * n); }
#pragma unroll
            for (int ai = 0; ai < 2; ++ai)
#pragma unroll
                for (int m = 0; m < 4; ++m) {
                    const int row = u.pm * BM + ai * HALF + wr * 64 + m * 16 + fr;
                    const int t = row & (SEQ - 1);
                    const bf16_t* gp = G + (size_t)row * DFF + col;
                    const bool hasm = t > 0, hasn = t < SEQ - 1;
                    u32x4 gm = *(const u32x4*)(gp - (hasm ? DFF : 0));
                    const u32x4 g0 = *(const u32x4*)gp;
                    u32x4 gn = *(const u32x4*)(gp + (hasn ? DFF : 0));
                    const unsigned mm = hasm ? 0xffffffffu : 0u, mn = hasn ? 0xffffffffu : 0u;
                    gm.x &= mm; gm.y &= mm; gm.z &= mm; gm.w &= mm; gn.x &= mn; gn.y &= mn; gn.z &= mn; gn.w &= mn;
                    unsigned ow[4];
#pragma unroll
                    for (int n = 0; n < 2; ++n) {
                        const unsigned m0 = n ? gm.z : gm.x, m1 = n ? gm.w : gm.y, c0 = n ? g0.z : g0.x, c1 = n ? g0.w : g0.y, n0 = n ? gn.z : gn.x, n1 = n ? gn.w : gn.y;
                        const f32x4 fm = {bflo(m0), bfhi(m0), bflo(m1), bfhi(m1)}, f0 = {bflo(c0), bfhi(c0), bflo(c1), bfhi(c1)}, fn = {bflo(n0), bfhi(n0), bflo(n1), bfhi(n1)};
                        const f32x4 gc = bb[n] + fm * w0[n] + f0 * w1[n] + fn * w2[n];
                        const f32x4 a = acc[ai][bj][m][n];
                        float o[4];
#pragma unroll
                        for (int e = 0; e < 4; ++e) {
                            constexpr float C1 = -2.0f * LOG2E * 0.7978845608028654f, C2 = C1 * 0.044715f;
                            const float x = gc[e];
                            const float ex = __builtin_amdgcn_exp2f(x * __builtin_fmaf(x * x, C2, C1));
                            o[e] = (x * a[e]) * __builtin_amdgcn_rcpf(1.0f + ex);
                        }
                        ow[2 * n] = pk2(o[0], o[1]); ow[2 * n + 1] = pk2(o[2], o[3]);
                    }
                    *(u32x4*)(H + (size_t)row * DFF + col) = (u32x4){ow[0], ow[1], ow[2], ow[3]};
                }
        }
    }
};
}

__device__ __forceinline__ s16x4 vtr(LAS const unsigned char* p) { typedef short v4i16_t __attribute__((ext_vector_type(4))); return __builtin_bit_cast(s16x4, __builtin_amdgcn_ds_read_tr16_b64_v4i16((LAS v4i16_t*)p)); }

template <int NK, int NT, int KSTR, class BM>
__device__ __forceinline__ void attn_step(LAS const unsigned char* Kl, LAS const unsigned char* Vl, int kb, const bf16x8 (&q)[NT][NK], f32x4 (&o)[NT][4], float (&mrun)[NT], float (&lrun)[NT], int lane, const BM& bm) {
    constexpr float THR = 8.0f;
    const int i = lane & 15, g = lane >> 4;
    f32x4 s0[NT], s1[NT];
#pragma unroll
    for (int t = 0; t < NT; ++t) { const float nm = -mrun[t]; s0[t] = (f32x4){nm, nm, nm, nm}; s1[t] = s0[t]; }
    LAS const unsigned char* kp = Kl + (kb + i) * KSTR + g * 16;
#pragma unroll
    for (int ks = 0; ks < NK; ++ks) {
        const bf16x8 a0 = *(LAS const bf16x8*)(kp + ks * 64);
        const bf16x8 a1 = *(LAS const bf16x8*)(kp + 16 * KSTR + ks * 64);
#pragma unroll
        for (int t = 0; t < NT; ++t) {
            s0[t] = __builtin_amdgcn_mfma_f32_16x16x32_bf16(a0, q[t][ks], s0[t], 0, 0, 0);
            s1[t] = __builtin_amdgcn_mfma_f32_16x16x32_bf16(a1, q[t][ks], s1[t], 0, 0, 0);
        }
    }
    bf16x8 pb[NT];
#pragma unroll
    for (int t = 0; t < NT; ++t) {
        bm(s0[t], s1[t], kb, t);
        float mx = fmaxf(fmaxf(fmaxf(s0[t][0], s0[t][1]), fmaxf(s0[t][2], s0[t][3])), fmaxf(fmaxf(s1[t][0], s1[t][1]), fmaxf(s1[t][2], s1[t][3])));
        if (__any(mx > THR)) {
            mx = fmaxf(mx, __shfl_xor(mx, 16)); mx = fmaxf(mx, __shfl_xor(mx, 32));
            const float dl = fmaxf(mx, 0.f);
            const float alpha = __builtin_amdgcn_exp2f(-dl);
            mrun[t] += dl; lrun[t] *= alpha;
#pragma unroll
            for (int db = 0; db < 4; ++db) o[t][db] = o[t][db] * alpha;
            s0[t] = s0[t] - dl; s1[t] = s1[t] - dl;
        }
        float p0[4], p1[4]; float ps = 0.f;
#pragma unroll
        for (int j = 0; j < 4; ++j) { p0[j] = __builtin_amdgcn_exp2f(s0[t][j]); p1[j] = __builtin_amdgcn_exp2f(s1[t][j]); ps += p0[j] + p1[j]; }
        lrun[t] += ps;
        u32x4 w; w.x = pk2(p0[0], p0[1]); w.y = pk2(p0[2], p0[3]); w.z = pk2(p1[0], p1[1]); w.w = pk2(p1[2], p1[3]);
        pb[t] = __builtin_bit_cast(bf16x8, w);
    }
    LAS const unsigned char* vp = Vl + (kb + 4 * g + (i >> 2)) * S64 + (i & 3) * 8;
#pragma unroll
    for (int db = 0; db < 4; ++db) {
        const s16x4 lo = vtr(vp + db * 32), hi = vtr(vp + 16 * S64 + db * 32);
        const bf16x8 va = {lo[0], lo[1], lo[2], lo[3], hi[0], hi[1], hi[2], hi[3]};
#pragma unroll
        for (int t = 0; t < NT; ++t) o[t][db] = __builtin_amdgcn_mfma_f32_16x16x32_bf16(va, pb[t], o[t][db], 0, 0, 0);
    }
}

__device__ __forceinline__ bf16x8 load_q(const bf16_t* p, float s) { const u32x4 v = *(const u32x4*)p; return __builtin_bit_cast(bf16x8, scale_bf8(v, s)); }

struct Params { const float* in[20]; float* out; unsigned char* ws; };
enum { I_X = 0, I_C, I_WADA, I_BADA, I_GPREMIX, I_GPOSTMIX, I_GPREFFN, I_GPOSTFFN, I_WIN, I_RPB, I_T5, I_GQ, I_GKV, I_WUQ, I_WUKV, I_WOUT, I_WUP, I_CONVW, I_CONVB, I_WDOWN };

__device__ const unsigned char T5B[3][65] = {
 {0,1,2,3,4,5,6,7,8,8,8,8,8,8,8,9,9,9,9,9,9,9,9,9,9,9,9,10,10,10,10,10,10,10,10,10,10,10,10,10,10,10,10,10,10,10,10,10,10,10,11,11,11,11,11,11,11,11,11,11,11,11,11,11,11},
 {0,4,8,8,9,9,9,10,10,10,10,10,10,11,11,11,11,11,11,11,11,11,11,12,12,12,12,12,12,12,12,12,12,12,12,12,12,12,12,12,12,12,13,13,13,13,13,13,13,13,13,13,13,13,13,13,13,13,13,13,13,13,13,13,13},
 {0,9,10,10,11,11,12,12,12,12,12,13,13,13,13,13,13,13,13,13,14,14,14,14,14,14,14,14,14,14,14,14,14,14,14,15,15,15,15,15,15,15,15,15,15,15,15,15,15,15,15,15,15,15,15,15,15,15,15,15,15,15,15,15,15}};

__device__ __forceinline__ void transpose_item(const float* W, int K, int N, bf16_t* WT, const float* ksc, LAS float* scr, int item, int lane) {
    const int nblk = N / 32, kb = item / nblk, nb = item % nblk, k0 = 64 * kb, n0 = 32 * nb;
#pragma unroll 8
    for (int i = 0; i < 32; ++i) { const int kk = 2 * i + (lane >> 5); float v = W[(size_t)(k0 + kk) * N + n0 + (lane & 31)]; if (ksc) v *= ksc[k0 + kk]; scr[kk * 33 + (lane & 31)] = v; }
    asm volatile("s_waitcnt lgkmcnt(0)" ::: "memory");
    const int c = lane & 7;
#pragma unroll
    for (int j = 0; j < 4; ++j) { const int n = (lane >> 3) + 8 * j; const LAS float* s = scr + (8 * c) * 33 + n;
        u32x4 o; o.x = pk2(s[0 * 33], s[1 * 33]); o.y = pk2(s[2 * 33], s[3 * 33]); o.z = pk2(s[4 * 33], s[5 * 33]); o.w = pk2(s[6 * 33], s[7 * 33]);
        *(u32x4*)(WT + (size_t)(n0 + n) * K + k0 + 8 * c) = o; }
    asm volatile("s_waitcnt lgkmcnt(0)" ::: "memory");
}

template <int R>
__device__ __forceinline__ void rowwise_rows(int row0, int rstride, const float* xin, const bf16_t* y, const float* gpost, int gate_off, const float* modb, float* xout,
                                             const float* gpre, int sc_off, int sh_off, bf16_t* XN, int lane) {
    f32x4 v[R][4]; u32x2 yw[R][4];
#pragma unroll
    for (int r = 0; r < R; ++r) { const size_t ro = (size_t)(row0 + r * rstride) * DM + 4 * lane;
#pragma unroll
        for (int j = 0; j < 4; ++j) v[r][j] = *(const f32x4*)(xin + ro + 256 * j);
        if (y) {
#pragma unroll
            for (int j = 0; j < 4; ++j) yw[r][j] = *(const u32x2*)(y + ro + 256 * j); } }
#pragma unroll
    for (int r = 0; r < R; ++r) {
        const int row = row0 + r * rstride; const size_t ro = (size_t)row * DM + 4 * lane;
        const float* md = modb + (size_t)(row >> 12) * 6144;
        if (y) {
            f32x4 yv[4]; float ss = 0.f;
#pragma unroll
            for (int j = 0; j < 4; ++j) { const u32x2 w = yw[r][j]; yv[j] = (f32x4){bflo(w.x), bfhi(w.x), bflo(w.y), bfhi(w.y)};
                ss += (yv[j][0] * yv[j][0] + yv[j][1] * yv[j][1]) + (yv[j][2] * yv[j][2] + yv[j][3] * yv[j][3]); }
            const float rr = rsqrtf(wave_sum(ss) * (1.0f / DM) + EPS);
#pragma unroll
            for (int j = 0; j < 4; ++j) { const f32x4 gp = *(const f32x4*)(gpost + 4 * lane + 256 * j), gt = *(const f32x4*)(md + gate_off + 4 * lane + 256 * j);
                v[r][j] = v[r][j] + gt * (yv[j] * rr * gp); }
        }
        if (xout) {
#pragma unroll
            for (int j = 0; j < 4; ++j) *(f32x4*)(xout + ro + 256 * j) = v[r][j];
        }
        if (XN) {
            float ss = 0.f;
#pragma unroll
            for (int j = 0; j < 4; ++j) ss += (v[r][j][0] * v[r][j][0] + v[r][j][1] * v[r][j][1]) + (v[r][j][2] * v[r][j][2] + v[r][j][3] * v[r][j][3]);
            const float rr = rsqrtf(wave_sum(ss) * (1.0f / DM) + EPS);
#pragma unroll
            for (int j = 0; j < 4; ++j) { const f32x4 gp = *(const f32x4*)(gpre + 4 * lane + 256 * j), s1 = *(const f32x4*)(md + sc_off + 4 * lane + 256 * j), s0 = *(const f32x4*)(md + sh_off + 4 * lane + 256 * j);
                const f32x4 h = (v[r][j] * rr * gp) * (s1 + 1.0f) + s0;
                u32x2 w; w.x = pk2(h[0], h[1]); w.y = pk2(h[2], h[3]); *(u32x2*)(XN + ro + 256 * j) = w; }
        }
    }
}

#define XB_TMO      128
#define XB_XCNT(j)  (256  + 64 * (j))
#define XB_XSUB(j)  (1280 + 64 * (j))
#define XB_XGEN(j)  (2304 + 64 * (j))
#define XB_TOP      3328
#define XB_TOPGEN   3392
#define XCD_BAR_WORDS 3456
#define XB_SPIN_CAP (1u << 20)
__device__ __forceinline__ unsigned xb_ld(unsigned* p)              { return __hip_atomic_load(p, __ATOMIC_RELAXED, __HIP_MEMORY_SCOPE_AGENT); }
__device__ __forceinline__ unsigned xb_add(unsigned* p, unsigned v) { return __hip_atomic_fetch_add(p, v, __ATOMIC_RELAXED, __HIP_MEMORY_SCOPE_AGENT); }
__device__ __forceinline__ unsigned xb_xcc_id() { return (unsigned)__builtin_amdgcn_s_getreg((3 << 11) | 20) & 0xFu; }
#define XB_SPIN(cond, bar) do { unsigned _sp = 0; while (cond) { __builtin_amdgcn_s_sleep(1); \
    if ((++_sp & 255u) == 0u) { if (xb_ld(&(bar)[XB_TMO])) break; if (_sp > XB_SPIN_CAP) { atomicAdd(&(bar)[XB_TMO], 1u); break; } } } } while (0)
struct XcdBarrier { unsigned* bar; unsigned x; volatile LAS unsigned* st; };
__device__ __forceinline__ XcdBarrier xcd_barrier_post(unsigned* bar, volatile LAS unsigned* st, int wave_s) {
    XcdBarrier b; b.bar = bar; b.x = xb_xcc_id(); b.st = st;
    if (flat_tid(wave_s) == 0) (void)xb_add(&bar[XB_XCNT(b.x)], 1u);
    return b;
}
__device__ __forceinline__ void xcd_barrier_complete(unsigned* bar, unsigned x, unsigned& nloc, unsigned& nx) {
    const unsigned G = gridDim.x * gridDim.y * gridDim.z;
    unsigned sum, cnt, mine, sp = 0u;
    for (;;) {
        sum = 0u; cnt = 0u; mine = 0u;
#pragma unroll
        for (unsigned j = 0; j < 16; ++j) { const unsigned c = xb_ld(&bar[XB_XCNT(j)]); sum += c; cnt += (c > 0u) ? 1u : 0u; mine = (j == x) ? c : mine; }
        if (sum == G) break;
        __builtin_amdgcn_s_sleep(1);
        if ((++sp & 255u) == 0u) { if (xb_ld(&bar[XB_TMO])) break; if (sp > XB_SPIN_CAP) { atomicAdd(&bar[XB_TMO], 1u); break; } }
    }
    nloc = mine > 0u ? mine : 1u; nx = cnt > 0u ? cnt : 1u;
}
__device__ __forceinline__ void xcd_barrier(const XcdBarrier& b, int wave_s) {
    asm volatile("s_waitcnt vmcnt(0)" ::: "memory");
    __syncthreads();
    if (flat_tid(wave_s) == 0) {
        unsigned* bar = b.bar; unsigned bx = b.x;
        asm volatile("" : "+s"(bx));
        __builtin_amdgcn_s_waitcnt(0);
        unsigned nloc = b.st[0], nx = b.st[1];
        if (nloc == 0u) { xcd_barrier_complete(bar, bx, nloc, nx); b.st[0] = nloc; b.st[1] = nx; }
        const unsigned old = xb_add(&bar[XB_XSUB(bx)], 1u);
        const unsigned gen = old / nloc;
        if (old + 1u == (gen + 1u) * nloc) {
            __builtin_amdgcn_fence(__ATOMIC_RELEASE, "agent");
            asm volatile("s_waitcnt vmcnt(0)" ::: "memory");
            const unsigned og = xb_add(&bar[XB_TOP], 1u);
            const unsigned tg = og / nx;
            if (og + 1u == (tg + 1u) * nx) xb_add(&bar[XB_TOPGEN], 1u);
            else XB_SPIN(xb_ld(&bar[XB_TOPGEN]) == tg, bar);
            __builtin_amdgcn_fence(__ATOMIC_ACQUIRE, "agent");
            xb_add(&bar[XB_XGEN(bx)], 1u);
            asm volatile("s_waitcnt vmcnt(0)" ::: "memory");
        } else {
            XB_SPIN(xb_ld(&bar[XB_XGEN(bx)]) == gen, bar);
            __builtin_amdgcn_fence(__ATOMIC_ACQUIRE, "agent");
            asm volatile("s_waitcnt vmcnt(0)" ::: "memory");
        }
    }
    __syncthreads();
}

constexpr int LDS_BYTES = 148 * 1024;

__global__ void __launch_bounds__(NTHR, 2) fwd_megakernel(Params P) {
    extern __shared__ __attribute__((aligned(16))) unsigned char lds_raw[];
    LAS unsigned char* lds = (LAS unsigned char*)lds_raw;
    cg::grid_group grid = cg::this_grid();
    volatile LAS unsigned* MISC = (volatile LAS unsigned*)(lds + 3 * 128 * (S96 + S64) + 64);
    const int wave_s = __builtin_amdgcn_readfirstlane((int)threadIdx.x >> 6);
    const int tid0 = flat_tid(wave_s);
    if (tid0 < 32) MISC[tid0] = 0u;
    unsigned* barw = (unsigned*)(P.ws + WS_BAR);
    if (blockIdx.x == 0) for (int i = tid0; i < XCD_BAR_WORDS; i += NTHR) __hip_atomic_store(barw + i, 0u, __ATOMIC_RELAXED, __HIP_MEMORY_SCOPE_AGENT);
    { unsigned* xc = (unsigned*)(P.ws + WS_XCNT); for (int i = blockIdx.x * NTHR + tid0; i < 16 * 256 * 64; i += gridDim.x * NTHR) __hip_atomic_store(xc + i, 0u, __ATOMIC_RELAXED, __HIP_MEMORY_SCOPE_AGENT); }
    asm volatile("s_waitcnt vmcnt(0)" ::: "memory");
    __syncthreads();
    grid.sync();
    __builtin_amdgcn_fence(__ATOMIC_ACQUIRE, "agent");
    asm volatile("s_waitcnt vmcnt(0)" ::: "memory");
    const XcdBarrier xbar = xcd_barrier_post(barw, MISC + 8, wave_s);
#define GSYNC() xcd_barrier(xbar, wave_s)
    const int G = gridDim.x, bid = blockIdx.x, NGW = G * NWAVE;
#define LOCAL_IDS int tid = flat_tid(wave_s); asm volatile("" : "+v"(tid)); const int lane = tid & 63, wave = __builtin_amdgcn_readfirstlane(tid >> 6), gw = bid * NWAVE + wave; (void)lane; (void)gw;
    unsigned char* ws = P.ws;
    float* modp = (float*)(ws + WS_MOD);
    float* cosT = (float*)(ws + WS_ROPE); float* sinT = cosT + SEQ * 16;
    float* rq = (float*)(ws + WS_RQ); float* rkv = rq + MTOK;
    float* lutg = (float*)(ws + WS_LUT);
    float* lse = (float*)(ws + WS_LSE);
    bf16_t* XN = (bf16_t*)(ws + WS_XN);
    bf16_t* Z = (bf16_t*)(ws + WS_Z);
    bf16_t* QB = (bf16_t*)(ws + WS_Q);
    bf16_t* KVB = (bf16_t*)(ws + WS_KV);
    bf16_t* PART = (bf16_t*)(ws + WS_PART);
    bf16_t* OB = XN;
    bf16_t* YMIX = Z;
    bf16_t* GB = (bf16_t*)(ws + WS_G);
    bf16_t* HID = (bf16_t*)(ws + WS_HID);
    bf16_t* YFFN = XN;

    {
        LOCAL_IDS
        LAS float* scr = (LAS float*)(lds + wave * 16384);
        constexpr int IT_IN = 16 * 93, IT_OUT = 16 * 32, IT_UP = 16 * 176, IT_DOWN = 44 * 32, IT_UQ = 6 * 12, IT_UKV = 4 * 16;
        constexpr int IT_L = IT_IN + IT_OUT + IT_UP + IT_DOWN + IT_UQ + IT_UKV;
        for (int it = gw; it < DEPTH * IT_L; it += NGW) {
            const int l = it / IT_L; int r = it % IT_L;
            unsigned char* wl = ws + WS_W + (size_t)l * WL_STRIDE;
            if (r < IT_IN) { transpose_item(P.in[I_WIN] + (size_t)l * DM * DIN, DM, DIN, (bf16_t*)(wl + WL_IN), nullptr, scr, r, lane); continue; } r -= IT_IN;
            if (r < IT_OUT) { transpose_item(P.in[I_WOUT] + (size_t)l * DM * DM, DM, DM, (bf16_t*)(wl + WL_OUT), nullptr, scr, r, lane); continue; } r -= IT_OUT;
            if (r < IT_UP) { transpose_item(P.in[I_WUP] + (size_t)l * DM * 2 * DFF, DM, 2 * DFF, (bf16_t*)(wl + WL_UP), nullptr, scr, r, lane); continue; } r -= IT_UP;
            if (r < IT_DOWN) { transpose_item(P.in[I_WDOWN] + (size_t)l * DFF * DM, DFF, DM, (bf16_t*)(wl + WL_DOWN), nullptr, scr, r, lane); continue; } r -= IT_DOWN;
            if (r < IT_UQ) { transpose_item(P.in[I_WUQ] + (size_t)l * 384 * 384, 384, 384, (bf16_t*)(wl + WL_UQ), P.in[I_GQ] + l * 384, scr, r, lane); continue; } r -= IT_UQ;
            transpose_item(P.in[I_WUKV] + (size_t)l * 256 * 512, 256, 512, (bf16_t*)(wl + WL_UKV), P.in[I_GKV] + l * 256, scr, r, lane);
        }
        {
            constexpr int PZ_IN = 96 * 1024 / 8, PZ_UQ = 128 * 384 / 8, PZ_L = PZ_IN + PZ_UQ;
            const u32x4 z4 = {0u, 0u, 0u, 0u};
            for (int it = bid * NTHR + tid; it < DEPTH * PZ_L; it += G * NTHR) {
                const int l = it / PZ_L, r = it % PZ_L;
                unsigned char* wl = ws + WS_W + (size_t)l * WL_STRIDE;
                if (r < PZ_IN) *(u32x4*)(wl + WL_IN + (size_t)DIN * DM * 2 + (size_t)r * 16) = z4;
                else *(u32x4*)(wl + WL_UQ + (size_t)384 * 384 * 2 + (size_t)(r - PZ_IN) * 16) = z4;
            }
        }
        for (int it = bid * NTHR + tid; it < SEQ * 16; it += G * NTHR) {
            const int s = it >> 4, i = it & 15;
            const float invf = powf(10000.0f, -(float)(2 * i) / 32.0f);
            const float ang = (float)s * invf;
            const double t = (double)ang * 0.15915494309189535;
            const float fr = (float)(t - floor(t));
            cosT[it] = __builtin_amdgcn_cosf(fr); sinT[it] = __builtin_amdgcn_sinf(fr);
        }
        for (int it = bid * NTHR + tid; it < 3 * 8 * 129; it += G * NTHR) {
            const int p = it / (8 * 129), h = (it / 129) % 8, idx = it % 129, rel = idx - 64, n = rel < 0 ? -rel : rel;
            const int bk = (int)T5B[p][n] + (rel > 0 ? 16 : 0);
            lutg[(p * 8 + h) * 132 + idx] = P.in[I_T5][bk * 8 + h] * LOG2E;
        }
        __syncthreads();
        for (int pair = bid; pair < 96; pair += G) {
            const int l = pair / 24, nc = pair % 24, ks = wave;
#pragma unroll 4
            for (int e = lane; e < 2048; e += 64) { const int b = e >> 7, k = e & 127; const float cv = P.in[I_C][b * DM + ks * 128 + k]; scr[e] = cv / (1.0f + __expf(-cv)); }
            asm volatile("s_waitcnt lgkmcnt(0)" ::: "memory");
            f32x4 accm[16];
#pragma unroll
            for (int b = 0; b < 16; ++b) accm[b] = (f32x4){0.f, 0.f, 0.f, 0.f};
            const float* wp = P.in[I_WADA] + ((size_t)l * DM + ks * 128) * 6144 + nc * 256 + 4 * lane;
#pragma unroll 4
            for (int k = 0; k < 128; ++k) {
                const f32x4 w = *(const f32x4*)(wp + (size_t)k * 6144);
#pragma unroll
                for (int b = 0; b < 16; ++b) accm[b] = accm[b] + w * scr[b * 128 + k];
            }
            asm volatile("s_waitcnt lgkmcnt(0)" ::: "memory");
#pragma unroll
            for (int b = 0; b < 16; ++b) *(LAS f32x4*)(scr + b * 256 + 4 * lane) = accm[b];
            __syncthreads();
            const LAS float* part = (const LAS float*)lds;
#pragma unroll
            for (int j = 0; j < 8; ++j) {
                const int o = tid + NTHR * j, b = o >> 8, n = o & 255;
                float sum = P.in[I_BADA][l * 6144 + nc * 256 + n];
#pragma unroll
                for (int w = 0; w < 8; ++w) sum += part[w * 4096 + o];
                modp[((size_t)l * 16 + b) * 6144 + nc * 256 + n] = sum;
            }
            __syncthreads();
        }
    }
    GSYNC();
    { LOCAL_IDS
    for (int row = gw; row < MTOK; row += 4 * NGW)
        rowwise_rows<4>(row, NGW, P.in[I_X], nullptr, nullptr, 0, modp, nullptr, P.in[I_GPREMIX], 1024, 0, XN, lane);
    }
    GSYNC();

    for (int l = 0; l < DEPTH; ++l) {
        unsigned char* wl = ws + WS_W + (size_t)l * WL_STRIDE;
        const float* modl = modp + (size_t)l * 16 * 6144;
        {
            pg8::Gemm g{XN, (const bf16_t*)(wl + WL_IN), MTOK, ZLD, DM, DM}; pg8::StaticOrder S; S.init(MTOK, ZLD, G, bid);
            pg8::EpiStore E{Z, ZLD, ZLD, 1, cosT, sinT};
            pg8::gemm_phase(lds, g, S, E, wave_s);
        }
        GSYNC();
        {
            pg8::Gemm g{Z + ZC_CQ, (const bf16_t*)(wl + WL_UQ), MTOK, 512, 384, ZLD}; pg8::StaticOrder S; S.init(MTOK, 512, G, bid);
            pg8::EpiStore E{QB, 384, 384, 2, cosT, sinT};
            pg8::gemm_phase(lds, g, S, E, wave_s);
        }
        {
            pg8::Gemm g{Z + ZC_CKV, (const bf16_t*)(wl + WL_UKV), MTOK, 512, 256, ZLD}; pg8::StaticOrder S; S.init(MTOK, 512, G, bid);
            pg8::EpiStoreKV E{KVB, 512, Z + ZC_CKV};
            pg8::gemm_phase(lds, g, S, E, wave_s);
        }
        { LOCAL_IDS
        for (int row0 = gw; row0 < MTOK; row0 += 4 * NGW) {
            u32x4 v0[4], v1[4];
#pragma unroll
            for (int r = 0; r < 4; ++r) { const bf16_t* zr = Z + (size_t)(row0 + r * NGW) * ZLD + ZC_CQ; v0[r] = *(const u32x4*)(zr + 8 * lane);
                v1[r] = (u32x4){0u, 0u, 0u, 0u}; if (lane < 16) v1[r] = *(const u32x4*)(zr + 8 * (lane + 64)); }
#pragma unroll
            for (int r = 0; r < 4; ++r) {
                const u32x4 a = v0[r], c = v1[r];
                const float s0 = bflo(a.x) * bflo(a.x) + bfhi(a.x) * bfhi(a.x) + bflo(a.y) * bflo(a.y) + bfhi(a.y) * bfhi(a.y) + bflo(a.z) * bflo(a.z) + bfhi(a.z) * bfhi(a.z) + bflo(a.w) * bflo(a.w) + bfhi(a.w) * bfhi(a.w);
                const float s1 = bflo(c.x) * bflo(c.x) + bfhi(c.x) * bfhi(c.x) + bflo(c.y) * bflo(c.y) + bfhi(c.y) * bfhi(c.y) + bflo(c.z) * bflo(c.z) + bfhi(c.z) * bfhi(c.z) + bflo(c.w) * bflo(c.w) + bfhi(c.w) * bfhi(c.w);
                float sq = lane < 48 ? s0 : 0.f, sk = (lane < 48 ? 0.f : s0) + s1;
                sq = wave_sum(sq); sk = wave_sum(sk);
                if (lane == 0) { const int row = row0 + r * NGW; rq[row] = rsqrtf(sq * (1.0f / 384.0f) + EPS); rkv[row] = rsqrtf(sk * (1.0f / 256.0f) + EPS); }
            }
        } }
        {
            LOCAL_IDS
            LAS unsigned char* Kl = lds; LAS unsigned char* Vl = lds + 400 * S64; LAS float* biasL = (LAS float*)(lds + 2 * 400 * S64);
            const int i = lane & 15, g4 = lane >> 4, w16 = 16 * wave;
            const int per = (24 * 256 + G - 1) / G, u0 = bid * per, u1 = min(u0 + per, 24 * 256);
            u32x4 pk[6], pvv[6], pq[2][2];
            if (tid < S64) { unsigned zz = 0u; asm volatile("" : "+v"(zz)); const u32x4 z4 = {zz, zz, zz, zz}; *(LAS u32x4*)(Kl + 384 * S64 + tid * 16) = z4; *(LAS u32x4*)(Vl + 384 * S64 + tid * 16) = z4; }
            auto decode = [&](int unit, int& p, int& h, int& b, int& r, int& mb, int& dl) {
                const int ph = unit >> 8, rest = unit & 255; p = ph >> 3; h = ph & 7; b = rest >> 4; const int rm = rest & 15;
                dl = 2 * p; const int nmb = 16 >> dl; r = rm / nmb; mb = rm % nmb; };
            auto issue = [&](int unit) {
                int p, h, b, r, mb, dl; decode(unit, p, h, b, r, mb, dl);
                const int L = SEQ >> dl;
                const bf16_t* zb = Z + (size_t)b * SEQ * ZLD + 64 * h;
#pragma unroll
                for (int it = 0; it < 6; ++it) {
                    const int c = tid + NTHR * it, row = c >> 3, ch = c & 7, mk = 256 * mb - 64 + row;
                    pk[it] = (u32x4){0u, 0u, 0u, 0u}; pvv[it] = (u32x4){0u, 0u, 0u, 0u};
                    if (mk >= 0 && mk < L) { const bf16_t* src = zb + (size_t)((mk << dl) + r) * ZLD + 8 * ch; pk[it] = *(const u32x4*)(src + ZC_KB); pvv[it] = *(const u32x4*)(src + ZC_VB); }
                }
#pragma unroll
                for (int t = 0; t < 2; ++t) { const int tq = ((256 * mb + 128 * t + w16 + i) << dl) + r;
                    const bf16_t* qp = zb + (size_t)tq * ZLD + ZC_QB + 8 * g4; pq[t][0] = *(const u32x4*)qp; pq[t][1] = *(const u32x4*)(qp + 32); }
            };
            auto commit = [&]() {
#pragma unroll
                for (int it = 0; it < 6; ++it) { const int c = tid + NTHR * it, row = c >> 3, ch = c & 7;
                    *(LAS u32x4*)(Kl + row * S64 + ch * 16) = pk[it]; *(LAS u32x4*)(Vl + row * S64 + ch * 16) = pvv[it]; }
            };
            int cur_ph = -1;
            issue(min(u0, 24 * 256 - 1));
            for (int unit = u0; unit < u1; ++unit) {
                int p, h, b, r, mb, dl; decode(unit, p, h, b, r, mb, dl);
                const int L = SEQ >> dl, nmb = 16 >> dl;
                commit();
                if ((unit >> 8) != cur_ph) {
                    cur_ph = unit >> 8;
                    const float* lg = lutg + cur_ph * 132;
                    for (int e = tid; e < 2560; e += NTHR) { const int st = e >> 9, ln = (e >> 3) & 63, jj = e & 7;
                        const int rel = 32 * st + 4 * (ln >> 4) + (jj & 3) + 16 * (jj >> 2) - 64 - (ln & 15); const bool ok = (rel >= -64) && (rel <= 64);
                        biasL[e] = ok ? lg[min(max(rel + 64, 0), 128)] : -INFINITY; }
                }
                bf16x8 qf[2][1][2]; f32x4 o[2][1][4]; float mr[2][1], lr[2][1];
#pragma unroll
                for (int t = 0; t < 2; ++t) {
                    qf[t][0][0] = __builtin_bit_cast(bf16x8, scale_bf8(pq[t][0], 0.125f * LOG2E)); qf[t][0][1] = __builtin_bit_cast(bf16x8, scale_bf8(pq[t][1], 0.125f * LOG2E));
                    mr[t][0] = 0.f; lr[t][0] = 0.f;
#pragma unroll
                    for (int db = 0; db < 4; ++db) o[t][0][db] = (f32x4){0.f, 0.f, 0.f, 0.f};
                }
                __syncthreads();
                if (unit + 1 < u1) issue(unit + 1);
                const bool edge = (mb == 0) || (mb == nmb - 1);
#pragma unroll 1
                for (int st = 0; st < 5; ++st) {
                    auto bm = [&](f32x4& s0, f32x4& s1, int kb, int) {
                        const LAS f32x4* bp = (const LAS f32x4*)(biasL + (st * 64 + lane) * 8);
                        s0 = s0 + bp[0]; s1 = s1 + bp[1];
                        if (edge) {
#pragma unroll
                            for (int j = 0; j < 4; ++j) { const int mk0 = 256 * mb - 64 + kb + 4 * g4 + j, mk1 = mk0 + 16;
                                if (mk0 < 0 || mk0 >= L) s0[j] = -INFINITY; if (mk1 < 0 || mk1 >= L) s1[j] = -INFINITY; }
                        }
                    };
#pragma unroll
                    for (int t = 0; t < 2; ++t) attn_step<2, 1, S64>(Kl, Vl, 128 * t + w16 + 32 * st, qf[t], o[t], mr[t], lr[t], lane, bm);
                }
#pragma unroll
                for (int t = 0; t < 2; ++t) {
                    const int tq = ((256 * mb + 128 * t + w16 + i) << dl) + r;
                    float lt = lr[t][0]; lt += __shfl_xor(lt, 16); lt += __shfl_xor(lt, 32);
                    const float inv = 1.0f / lt;
                    bf16_t* op = PART + ((size_t)p * MTOK + (size_t)b * SEQ + tq) * 512 + 64 * h + 4 * g4;
#pragma unroll
                    for (int db = 0; db < 4; ++db) { u32x2 w; w.x = pk2(o[t][0][db][0] * inv, o[t][0][db][1] * inv); w.y = pk2(o[t][0][db][2] * inv, o[t][0][db][3] * inv); *(u32x2*)(op + 16 * db) = w; }
                    if (g4 == 0) lse[((size_t)p * MTOK + (size_t)b * SEQ + tq) * 8 + h] = mr[t][0] + __log2f(lt);
                }
                __syncthreads();
            }
        }
        GSYNC();
        {
            LOCAL_IDS
            constexpr int KB_BYTES = 128 * S96, BUF_BYTES = 128 * S96 + 128 * S64;
            const int i = lane & 15, g4 = lane >> 4;
            const float qscale = 0.10206207261596575f * LOG2E;
            for (int unit = bid; unit < 1024; unit += G) {
                const int b = unit >> 6, h = (unit >> 4) & 3, qb = unit & 15;
                const size_t tb = (size_t)b * SEQ;
                bf16x8 qf[2][3];
#pragma unroll
                for (int t = 0; t < 2; ++t) { const size_t row = tb + qb * 256 + 32 * wave + 16 * t + i; const float sc = rq[row] * qscale;
                    const bf16_t* qp = QB + row * 384 + 96 * h + 8 * g4;
#pragma unroll
                    for (int ks = 0; ks < 3; ++ks) qf[t][ks] = load_q(qp + 32 * ks, sc); }
                f32x4 o[2][4];
#pragma unroll
                for (int t = 0; t < 2; ++t)
#pragma unroll
                    for (int db = 0; db < 4; ++db) o[t][db] = (f32x4){0.f, 0.f, 0.f, 0.f};
                unsigned doff[6]; unsigned dz = 0u;
#pragma unroll
                for (int j = 0; j < 6; ++j) {
                    const int pc = wave + 8 * j;
                    if (pc < 28) { const int off = pc * 1024 + lane * 16, row = off / S96, col = off - row * S96;
                        if (col >= 128 && col < 192) { doff[j] = (unsigned)(row * (ZLD * 2) + (col - 128)); dz |= 1u << j; }
                        else doff[j] = (unsigned)(row * 1024 + (col < 128 ? col : 0)); }
                    else { const int off = (pc - 28) * 1024 + lane * 16, row = off / S64, col = off - row * S64;
                        doff[j] = (unsigned)(row * 1024 + 128 + (col < 128 ? col : 0)); }
                }
                auto dma = [&](int c, int buf) {
                    const size_t key0 = tb + (size_t)c * 128;
                    const char* kvb = (const char*)(KVB + key0 * 512 + 128 * h);
                    const char* zkr = (const char*)(Z + key0 * ZLD + ZC_KR);
#pragma unroll
                    for (int j = 0; j < 6; ++j) {
                        const int pc = wave + 8 * j;
                        const char* src = (((dz >> j) & 1u) ? zkr : kvb) + doff[j];
                        __builtin_amdgcn_global_load_lds((const unsigned*)src, (LAS unsigned*)(lds + buf * BUF_BYTES + pc * 1024), 16, 0, 0);
                    }
                };
                constexpr float THR = 8.0f;
                bf16x8 kf[6]; f32x4 s0[2], s1[2], negm[2], lacc[2];
                const bf16x8 ones = {0x3f80, 0x3f80, 0x3f80, 0x3f80, 0x3f80, 0x3f80, 0x3f80, 0x3f80};
#pragma unroll
                for (int t = 0; t < 2; ++t) { negm[t] = (f32x4){0.f, 0.f, 0.f, 0.f}; lacc[t] = (f32x4){0.f, 0.f, 0.f, 0.f}; }
                auto kload = [&](LAS const unsigned char* Kl, int kb) {
                    LAS const unsigned char* kp = Kl + (kb + i) * S96 + g4 * 16;
#pragma unroll
                    for (int ks = 0; ks < 3; ++ks) { kf[2 * ks] = *(LAS const bf16x8*)(kp + ks * 64); kf[2 * ks + 1] = *(LAS const bf16x8*)(kp + 16 * S96 + ks * 64); }
                };
                auto qkm = [&]() {
#pragma unroll
                    for (int t = 0; t < 2; ++t) {
                        s0[t] = __builtin_amdgcn_mfma_f32_16x16x32_bf16(kf[0], qf[t][0], negm[t], 0, 0, 0);
                        s1[t] = __builtin_amdgcn_mfma_f32_16x16x32_bf16(kf[1], qf[t][0], negm[t], 0, 0, 0);
                    }
#pragma unroll
                    for (int ks = 1; ks < 3; ++ks)
#pragma unroll
                        for (int t = 0; t < 2; ++t) {
                            s0[t] = __builtin_amdgcn_mfma_f32_16x16x32_bf16(kf[2 * ks], qf[t][ks], s0[t], 0, 0, 0);
                            s1[t] = __builtin_amdgcn_mfma_f32_16x16x32_bf16(kf[2 * ks + 1], qf[t][ks], s1[t], 0, 0, 0);
                        }
                };
                auto smpv = [&](LAS const unsigned char* vp) {
                    bf16x8 pb[2];
#pragma unroll
                    for (int t = 0; t < 2; ++t) {
                        float mx = __builtin_fmaxf(__builtin_fmaxf(s0[t][0], s0[t][1]), s0[t][2]);
                        mx = __builtin_fmaxf(__builtin_fmaxf(mx, s0[t][3]), s1[t][0]);
                        mx = __builtin_fmaxf(__builtin_fmaxf(mx, s1[t][1]), s1[t][2]);
                        mx = __builtin_fmaxf(mx, s1[t][3]);
                        if (__any(mx > THR)) {
                            mx = fmaxf(mx, __shfl_xor(mx, 16)); mx = fmaxf(mx, __shfl_xor(mx, 32));
                            const float dl = fmaxf(mx, 0.f);
                            const float alpha = __builtin_amdgcn_exp2f(-dl);
                            negm[t] = negm[t] - dl;
                            lacc[t] = lacc[t] * alpha;
#pragma unroll
                            for (int db = 0; db < 4; ++db) o[t][db] = o[t][db] * alpha;
                            s0[t] = s0[t] - dl; s1[t] = s1[t] - dl;
                        }
                        u32x4 w;
                        w.x = pk2(__builtin_amdgcn_exp2f(s0[t][0]), __builtin_amdgcn_exp2f(s0[t][1])); w.y = pk2(__builtin_amdgcn_exp2f(s0[t][2]), __builtin_amdgcn_exp2f(s0[t][3]));
                        w.z = pk2(__builtin_amdgcn_exp2f(s1[t][0]), __builtin_amdgcn_exp2f(s1[t][1])); w.w = pk2(__builtin_amdgcn_exp2f(s1[t][2]), __builtin_amdgcn_exp2f(s1[t][3]));
                        pb[t] = __builtin_bit_cast(bf16x8, w);
                    }
#pragma unroll
                    for (int t = 0; t < 2; ++t) lacc[t] = __builtin_amdgcn_mfma_f32_16x16x32_bf16(ones, pb[t], lacc[t], 0, 0, 0);
#pragma unroll
                    for (int db = 0; db < 4; ++db) {
                        const s16x4 lo = vtr(vp + db * 32), hi = vtr(vp + 16 * S64 + db * 32);
                        const bf16x8 va = {lo[0], lo[1], lo[2], lo[3], hi[0], hi[1], hi[2], hi[3]};
#pragma unroll
                        for (int t = 0; t < 2; ++t) o[t][db] = __builtin_amdgcn_mfma_f32_16x16x32_bf16(va, pb[t], o[t][db], 0, 0, 0);
                    }
                };
#define MLA_VP(VL, KBV) ((VL) + ((KBV) + 4 * g4 + (i >> 2)) * S64 + (i & 3) * 8)
#define MLA_STEP(KLN, KBN, VL, KBV) do { kload(KLN, KBN); __builtin_amdgcn_sched_barrier(0); smpv(MLA_VP(VL, KBV)); qkm(); __builtin_amdgcn_sched_barrier(0); } while (0)
                dma(0, 0); dma(1, 1);
                asm volatile("s_waitcnt vmcnt(0)" ::: "memory"); __syncthreads();
                kload(lds, 0); qkm();
                int bc = 0;
                for (int c = 0; c < 32; ++c) {
                    const int bn = (bc == 2) ? 0 : bc + 1, bp = (bc == 0) ? 2 : bc - 1;
                    LAS const unsigned char* Kl = lds + bc * BUF_BYTES; LAS const unsigned char* Vl = Kl + KB_BYTES;
                    MLA_STEP(Kl, 32, Vl, 0);
                    MLA_STEP(Kl, 64, Vl, 32);
                    MLA_STEP(Kl, 96, Vl, 64);
                    asm volatile("s_waitcnt vmcnt(0)" ::: "memory");
                    __syncthreads();
                    if (c + 2 < 32) dma(c + 2, bp);
                    if (c + 1 < 32) { MLA_STEP(lds + bn * BUF_BYTES, 0, Vl, 96); }
                    else { smpv(MLA_VP(Vl, 96)); }
                    bc = bn;
                }
#undef MLA_STEP
#undef MLA_VP
                __syncthreads();
#pragma unroll
                for (int t = 0; t < 2; ++t) {
                    const float inv = 1.0f / lacc[t][0];
                    bf16_t* op = OB + (tb + qb * 256 + 32 * wave + 16 * t + i) * DM + 768 + 64 * h + 4 * g4;
#pragma unroll
                    for (int db = 0; db < 4; ++db) { u32x2 w; w.x = pk2(o[t][db][0] * inv, o[t][db][1] * inv); w.y = pk2(o[t][db][2] * inv, o[t][db][3] * inv); *(u32x2*)(op + 16 * db) = w; }
                }
            }
        }
        {
            LOCAL_IDS
            constexpr int NREG = 2 * 128 * 128, NBUF = 2 * NREG;
            LAS float* lutl = (LAS float*)(lds + 2 * NBUF);
            const int i = lane & 15, g4 = lane >> 4, hh = wave >> 2, ct = wave & 3;
            const int cbase = ct == 0 ? 0 : (ct == 1 ? 8 : (ct == 2 ? 24 : 32));
            const float* rpb = P.in[I_RPB] + (size_t)l * 4 * 465;
            for (int e = tid; e < 1860; e += NTHR) lutl[e] = rpb[e] * LOG2E;
            int bid2 = bid; asm volatile("" : "+s"(bid2));
            const int per = (2048 + G - 1) / G, u0 = min(bid2 * per, 2047), u1 = min(bid2 * per + per, 2048), nf = (u1 - u0) * 4;
            const int qc = 16 * ct + i, cs = min(max(qc - 8, 0), 48);
            const int xk0 = ((g4) ^ (i & 7)) * 16, xk1 = ((4 + g4) ^ (i & 7)) * 16;
            int xv[4], bidx[8]; unsigned okm = 0u;
#pragma unroll
            for (int db = 0; db < 4; ++db) xv[db] = ((2 * db + ((i & 3) >> 1)) ^ ((4 * g4 + (i >> 2)) & 7)) * 16 + (i & 1) * 8;
#pragma unroll
            for (int jj = 0; jj < 8; ++jj) { const int kc = cbase + 16 * (jj >> 2) + 4 * g4 + (jj & 3); const bool ok = (kc >= cs) && (kc < cs + 16);
                bidx[jj] = min(max(kc - qc + 15, 0), 30); okm |= (ok ? 1u : 0u) << jj; }
            const int csrc = (lane & 7) ^ (lane >> 3);
            u32x4 pq[2];
            auto stage = [&](int f, int buf) {
                const int unit = u0 + (f >> 2), c = f & 3, b = unit >> 7, rr = (unit >> 1) & 63, hp = unit & 1;
                const int r0 = min(max(rr - 4, 0), 56), tk0 = (r0 + 2 * c) * 64;
                const bf16_t* zb = Z + (size_t)b * SEQ * ZLD;
#pragma unroll
                for (int j = 0; j < 8; ++j) {
                    const int pc = wave + 8 * j, q = pc & 31, h2 = q >> 4, row = 8 * (q & 15) + (lane >> 3);
                    const bf16_t* src = zb + (size_t)(tk0 + row) * ZLD + (pc < 32 ? ZC_KA : ZC_VA) + 64 * (2 * hp + h2) + 8 * csrc;
                    __builtin_amdgcn_global_load_lds((const unsigned*)src, (LAS unsigned*)(lds + buf * NBUF + pc * 1024), 16, 0, 0);
                }
                if (c == 0) { const bf16_t* qp = zb + (size_t)(rr * 64 + qc) * ZLD + ZC_QA + 64 * (2 * hp + hh) + 8 * g4; pq[0] = *(const u32x4*)qp; pq[1] = *(const u32x4*)(qp + 32); }
            };
            bf16x8 qf0 = {0, 0, 0, 0, 0, 0, 0, 0}, qf1 = qf0; f32x4 o[4]; float mr = 0.f, lr = 0.f;
#pragma unroll
            for (int db = 0; db < 4; ++db) o[db] = (f32x4){0.f, 0.f, 0.f, 0.f};
            constexpr float THR = 8.0f;
            stage(0, 0);
            for (int f = 0; f < nf; ++f) {
                const int buf = f & 1;
                const int unit = u0 + (f >> 2), c = f & 3, b = unit >> 7, rr = (unit >> 1) & 63, hp = unit & 1, head = 2 * hp + hh;
                const int r0 = min(max(rr - 4, 0), 56);
                asm volatile("s_waitcnt vmcnt(0)" ::: "memory");
                if (c == 0) {
                    qf0 = __builtin_bit_cast(bf16x8, scale_bf8(pq[0], 0.125f * LOG2E)); qf1 = __builtin_bit_cast(bf16x8, scale_bf8(pq[1], 0.125f * LOG2E));
                    mr = 0.f; lr = 0.f;
#pragma unroll
                    for (int db = 0; db < 4; ++db) o[db] = (f32x4){0.f, 0.f, 0.f, 0.f};
                }
                __syncthreads();
                if (f + 1 < nf) stage(f + 1, buf ^ 1);
                LAS const unsigned char* Kb = lds + buf * NBUF + hh * (128 * 128); LAS const unsigned char* Vb = Kb + NREG;
#pragma unroll
                for (int kr = 0; kr < 2; ++kr) {
                    const int kb = kr * 64 + cbase;
                    const int dr = (r0 + 2 * c + kr) - rr + 7;
                    const LAS float* lrow = lutl + head * 465 + dr * 31;
                    LAS const unsigned char* kp = Kb + (kb + i) * 128;
                    const bf16x8 a00 = *(LAS const bf16x8*)(kp + xk0), a10 = *(LAS const bf16x8*)(kp + 16 * 128 + xk0);
                    const bf16x8 a01 = *(LAS const bf16x8*)(kp + xk1), a11 = *(LAS const bf16x8*)(kp + 16 * 128 + xk1);
                    const float nm = -mr;
                    f32x4 s0 = {nm, nm, nm, nm}, s1 = s0;
                    s0 = __builtin_amdgcn_mfma_f32_16x16x32_bf16(a00, qf0, s0, 0, 0, 0); s1 = __builtin_amdgcn_mfma_f32_16x16x32_bf16(a10, qf0, s1, 0, 0, 0);
                    s0 = __builtin_amdgcn_mfma_f32_16x16x32_bf16(a01, qf1, s0, 0, 0, 0); s1 = __builtin_amdgcn_mfma_f32_16x16x32_bf16(a11, qf1, s1, 0, 0, 0);
#pragma unroll
                    for (int j = 0; j < 4; ++j) {
                        s0[j] = ((okm >> j) & 1u) ? s0[j] + lrow[bidx[j]] : -INFINITY;
                        s1[j] = ((okm >> (4 + j)) & 1u) ? s1[j] + lrow[bidx[4 + j]] : -INFINITY;
                    }
                    float mx = fmaxf(fmaxf(fmaxf(s0[0], s0[1]), fmaxf(s0[2], s0[3])), fmaxf(fmaxf(s1[0], s1[1]), fmaxf(s1[2], s1[3])));
                    if (__any(mx > THR)) {
                        mx = fmaxf(mx, __shfl_xor(mx, 16)); mx = fmaxf(mx, __shfl_xor(mx, 32));
                        const float dlt = fmaxf(mx, 0.f);
                        const float alpha = __builtin_amdgcn_exp2f(-dlt);
                        mr += dlt; lr *= alpha;
#pragma unroll
                        for (int db = 0; db < 4; ++db) o[db] = o[db] * alpha;
                        s0 = s0 - dlt; s1 = s1 - dlt;
                    }
                    float p0[4], p1[4]; float ps = 0.f;
#pragma unroll
                    for (int j = 0; j < 4; ++j) { p0[j] = __builtin_amdgcn_exp2f(s0[j]); p1[j] = __builtin_amdgcn_exp2f(s1[j]); ps += p0[j] + p1[j]; }
                    lr += ps;
                    u32x4 w; w.x = pk2(p0[0], p0[1]); w.y = pk2(p0[2], p0[3]); w.z = pk2(p1[0], p1[1]); w.w = pk2(p1[2], p1[3]);
                    const bf16x8 pb = __builtin_bit_cast(bf16x8, w);
                    LAS const unsigned char* vp = Vb + (kb + 4 * g4 + (i >> 2)) * 128;
#pragma unroll
                    for (int db = 0; db < 4; ++db) {
                        const s16x4 lo = vtr(vp + xv[db]), hi = vtr(vp + 16 * 128 + xv[db]);
                        const bf16x8 va = {lo[0], lo[1], lo[2], lo[3], hi[0], hi[1], hi[2], hi[3]};
                        o[db] = __builtin_amdgcn_mfma_f32_16x16x32_bf16(va, pb, o[db], 0, 0, 0);
                    }
                }
                if (c == 3) {
                    float lt = lr; lt += __shfl_xor(lt, 16); lt += __shfl_xor(lt, 32);
                    const float inv = 1.0f / lt;
                    bf16_t* op = OB + ((size_t)b * SEQ + rr * 64 + qc) * DM + 64 * head + 4 * g4;
#pragma unroll
                    for (int db = 0; db < 4; ++db) { u32x2 w; w.x = pk2(o[db][0] * inv, o[db][1] * inv); w.y = pk2(o[db][2] * inv, o[db][3] * inv); *(u32x2*)(op + 16 * db) = w; }
                }
            }
            asm volatile("s_waitcnt vmcnt(0)" ::: "memory");
            __syncthreads();
        }
        { LOCAL_IDS
        const int h = lane >> 3;
        for (int row0 = gw; row0 < MTOK; row0 += 4 * NGW) {
            u32x4 pa[4], pb_[4], pc[4]; float l0[4], l1[4], l2[4];
#pragma unroll
            for (int r = 0; r < 4; ++r) { const size_t row = (size_t)(row0 + r * NGW);
                l0[r] = lse[((size_t)0 * MTOK + row) * 8 + h]; l1[r] = lse[((size_t)1 * MTOK + row) * 8 + h]; l2[r] = lse[((size_t)2 * MTOK + row) * 8 + h];
                pa[r] = *(const u32x4*)(PART + ((size_t)0 * MTOK + row) * 512 + 8 * lane);
                pb_[r] = *(const u32x4*)(PART + ((size_t)1 * MTOK + row) * 512 + 8 * lane);
                pc[r] = *(const u32x4*)(PART + ((size_t)2 * MTOK + row) * 512 + 8 * lane); }
#pragma unroll
            for (int r = 0; r < 4; ++r) {
                const float mx = fmaxf(l0[r], fmaxf(l1[r], l2[r]));
                float w0 = __builtin_amdgcn_exp2f(l0[r] - mx), w1 = __builtin_amdgcn_exp2f(l1[r] - mx), w2 = __builtin_amdgcn_exp2f(l2[r] - mx);
                const float inv = 1.0f / (w0 + w1 + w2); w0 *= inv; w1 *= inv; w2 *= inv;
                const u32x4 a = pa[r], bq = pb_[r], cq = pc[r];
                u32x4 o;
                o.x = pk2(w0 * bflo(a.x) + w1 * bflo(bq.x) + w2 * bflo(cq.x), w0 * bfhi(a.x) + w1 * bfhi(bq.x) + w2 * bfhi(cq.x));
                o.y = pk2(w0 * bflo(a.y) + w1 * bflo(bq.y) + w2 * bflo(cq.y), w0 * bfhi(a.y) + w1 * bfhi(bq.y) + w2 * bfhi(cq.y));
                o.z = pk2(w0 * bflo(a.z) + w1 * bflo(bq.z) + w2 * bflo(cq.z), w0 * bfhi(a.z) + w1 * bfhi(bq.z) + w2 * bfhi(cq.z));
                o.w = pk2(w0 * bflo(a.w) + w1 * bflo(bq.w) + w2 * bflo(cq.w), w0 * bfhi(a.w) + w1 * bfhi(bq.w) + w2 * bfhi(cq.w));
                *(u32x4*)(OB + (size_t)(row0 + r * NGW) * DM + 256 + 8 * lane) = o;
            }
        } }
        GSYNC();
        {
            pg8::Gemm g{OB, (const bf16_t*)(wl + WL_OUT), MTOK, DM, DM, DM}; pg8::StaticOrder S; S.init(MTOK, DM, G, bid);
            float* xs = (float*)(ws + WS_XSLOT); unsigned* xc = (unsigned*)(ws + WS_XCNT); const int q0 = (l * 2 + 0) * 2;
            pg8::EpiNorm E{(l == 0 ? P.in[I_X] : P.out), P.out, XN, P.in[I_GPOSTMIX] + l * DM, P.in[I_GPREFFN] + l * DM, modl, 2048, 4096, 3072,
                           xs + (size_t)q0 * MTOK * 4, xc + (size_t)q0 * 256 * 64, xs + (size_t)(q0 + 1) * MTOK * 4, xc + (size_t)(q0 + 1) * 256 * 64, lds + 131072};
            pg8::gemm_phase(lds, g, S, E, wave_s);
        }
        GSYNC();
        {
            pg8::Gemm g{XN, (const bf16_t*)(wl + WL_UP) + (size_t)DFF * DM, MTOK, DFF, DM, DM}; pg8::StaticOrder S; S.init(MTOK, DFF, G, bid);
            pg8::EpiStore16 E{GB, DFF};
            pg8::gemm_phase(lds, g, S, E, wave_s);
        }
        GSYNC();
        {
            pg8::Gemm g{XN, (const bf16_t*)(wl + WL_UP), MTOK, DFF, DM, DM}; pg8::StaticOrder S; S.init(MTOK, DFF, G, bid);
            pg8::EpiGate E{HID, GB, P.in[I_CONVW] + (size_t)l * 3 * DFF, P.in[I_CONVB] + (size_t)l * DFF};
            pg8::gemm_phase(lds, g, S, E, wave_s);
        }
        GSYNC();
        {
            pg8::Gemm g{HID, (const bf16_t*)(wl + WL_DOWN), MTOK, DM, DFF, DFF}; pg8::StaticOrder S; S.init(MTOK, DM, G, bid);
            float* xs = (float*)(ws + WS_XSLOT); unsigned* xc = (unsigned*)(ws + WS_XCNT); const int q0 = (l * 2 + 1) * 2;
            const int ln = (l + 1 < DEPTH) ? l + 1 : l;
            pg8::EpiNorm E{P.out, P.out, (l + 1 < DEPTH) ? XN : nullptr, P.in[I_GPOSTFFN] + l * DM, P.in[I_GPREMIX] + ln * DM, modl, 5120, (ln - l) * 16 * 6144 + 1024, (ln - l) * 16 * 6144,
                           xs + (size_t)q0 * MTOK * 4, xc + (size_t)q0 * 256 * 64, xs + (size_t)(q0 + 1) * MTOK * 4, xc + (size_t)(q0 + 1) * 256 * 64, lds + 131072};
            pg8::gemm_phase(lds, g, S, E, wave_s);
        }
        if (l + 1 < DEPTH) GSYNC();
    }
}

extern "C" void kernel_launch(void* const* d_in, const int* in_sizes, int n_in, void* d_out, int out_size, void* d_ws, size_t ws_size, hipStream_t stream) {
    static int grid_blocks = 0;
    if (grid_blocks == 0) {
        if (n_in != 20 || ws_size < WS_END) { fprintf(stderr, "kernel_launch: unexpected n_in %d or ws_size %zu\n", n_in, ws_size); grid_blocks = -1; return; }
        int dev = 0, cus = 0, per_cu = 0;
        hipGetDevice(&dev);
        hipDeviceGetAttribute(&cus, hipDeviceAttributeMultiprocessorCount, dev);
        if (hipFuncSetAttribute((const void*)fwd_megakernel, hipFuncAttributeMaxDynamicSharedMemorySize, LDS_BYTES) != hipSuccess) fprintf(stderr, "kernel_launch: hipFuncSetAttribute failed\n");
        hipOccupancyMaxActiveBlocksPerMultiprocessor(&per_cu, (const void*)fwd_megakernel, NTHR, LDS_BYTES);
        (void)hipGetLastError();
        if (per_cu < 1) { fprintf(stderr, "kernel_launch: occupancy query gives %d\n", per_cu); per_cu = 1; }
        grid_blocks = 256;
        if (cus < 256) fprintf(stderr, "kernel_launch: device has %d CUs, this kernel needs 256\n", cus);
    }
    if (grid_blocks < 0) return;
    Params p{};
    for (int i = 0; i < 20; ++i) p.in[i] = (const float*)d_in[i];
    p.out = (float*)d_out; p.ws = (unsigned char*)d_ws;
    void* args[] = {&p};
    hipError_t e = hipLaunchCooperativeKernel((const void*)fwd_megakernel, dim3(grid_blocks), dim3(NTHR), args, LDS_BYTES, stream);
    if (e != hipSuccess) fprintf(stderr, "cooperative launch failed: %s (grid %d)\n", hipGetErrorString(e), grid_blocks);
}
```
